# Optimizing an MI355X kernel written in HIP

```python
import jax, jax.numpy as jnp
from jax import lax
import numpy as np

D_MODEL = 1024
BATCH = 8
SEQ = 8192
DEPTH = 2

MEM_LEN = 256
N_EVEN = (DEPTH + 1) // 2
N_ODD = DEPTH // 2
A_HEADS = 4
A_KDIM = 128
A_VDIM = 128
A_CHUNK = 64
A_FDIM = A_HEADS * A_KDIM
A_WIDTH = A_HEADS * A_VDIM
B_WIDTH = 512
B_GROUPS = 4
B_CONV = 3
C_HEADS = 8
C_HEAD_DIM = 64
C_Q_RANK = 256
C_KV_RANK = 128
C_IDX_HEADS = 8
C_IDX_DIM = 64
C_MAX_TOPK = 256
C_QBLOCK = 128
C_WIDTH = C_HEADS * C_HEAD_DIM
D_GROUPS = 4
D_CHUNK = 128
D_WIDTH = 512
D_GROUP_DIM = D_WIDTH // D_GROUPS
X_HEADS = 4
X_HEAD_DIM = D_MODEL // X_HEADS
FF_DIM = ((8 * D_MODEL // 3 + 255) // 256) * 256

EVEN_SPLITS = (A_FDIM, A_FDIM, A_WIDTH, A_WIDTH, B_WIDTH, B_WIDTH, B_WIDTH)
EVEN_IN = sum(EVEN_SPLITS)
ODD_SPLITS = (C_Q_RANK, C_KV_RANK, C_IDX_DIM, C_IDX_HEADS, D_WIDTH, D_WIDTH)
ODD_IN = sum(ODD_SPLITS)

kernel_name = 'hybrid_hgrn2_shortconv_dsa_gmlp_trunk'

F32 = jnp.float32


def rms_norm(x, g, eps=1e-6):
    xf = x.astype(F32)
    y = xf * lax.rsqrt(jnp.mean(xf * xf, axis=-1, keepdims=True) + eps)
    return (y * g.astype(F32)).astype(x.dtype)


def layer_norm(x, g, b, eps=1e-5):
    xf = x.astype(F32)
    mu = jnp.mean(xf, axis=-1, keepdims=True)
    var = jnp.mean(jnp.square(xf - mu), axis=-1, keepdims=True)
    y = (xf - mu) * lax.rsqrt(var + eps)
    return (y * g.astype(F32) + b.astype(F32)).astype(x.dtype)


def split_cols(t, sizes):
    out, start = [], 0
    for s in sizes:
        out.append(t[..., start:start + s])
        start += s
    return out


def hgrn2_mixer(q_raw, f_raw, i_raw, g_raw, lb, out_gain):
    bn, s, _ = q_raw.shape
    nc = s // A_CHUNK
    q = jax.nn.silu(q_raw.astype(F32))
    f = lb + (1.0 - lb) * jax.nn.sigmoid(f_raw.astype(F32))
    k = 1.0 - f
    logf = jnp.log(f)
    v = i_raw.astype(F32)

    def chunks(t, d):
        return t.reshape(bn, nc, A_CHUNK, A_HEADS, d).transpose(1, 0, 3, 2, 4)

    xs = (chunks(q, A_KDIM), chunks(k, A_KDIM), chunks(logf, A_KDIM), chunks(v, A_VDIM))
    causal = jnp.tril(jnp.ones((A_CHUNK, A_CHUNK), bool))

    def step(state, inp):
        qc, kc, lfc, vc = inp
        b = jnp.cumsum(lfc, axis=2)
        o_inter = jnp.einsum('bhck,bhkv->bhcv', qc * jnp.exp(b), state)
        diff = b[:, :, :, None, :] - b[:, :, None, :, :]
        decay = jnp.exp(jnp.where(causal[:, :, None], diff, -jnp.inf))
        attn = jnp.einsum('bhtk,bhsk,bhtsk->bhts', qc, kc, decay)
        o_intra = jnp.einsum('bhts,bhsv->bhtv', attn, vc)
        b_last = b[:, :, -1:, :]
        new_state = jnp.exp(b_last[:, :, 0, :])[..., None] * state + jnp.einsum(
            'bhsk,bhsv->bhkv', kc * jnp.exp(b_last - b), vc)
        return new_state, o_inter + o_intra

    state0 = jnp.zeros((bn, A_HEADS, A_KDIM, A_VDIM), F32)
    _, o = lax.scan(step, state0, xs)
    o = o.transpose(1, 0, 3, 2, 4).reshape(bn, s, A_HEADS, A_VDIM)
    gate = jax.nn.silu(g_raw.astype(F32)).reshape(bn, s, A_HEADS, A_VDIM)
    o = rms_norm(o, out_gain) * gate
    return o.reshape(bn, s, A_WIDTH)


def short_conv_mixer(b_gate, c_gate, h, w_conv):
    z = c_gate * h
    y = lax.conv_general_dilated(
        z, w_conv[:, None, :].astype(z.dtype), window_strides=(1,),
        padding=[(B_CONV - 1, 0)], dimension_numbers=('NWC', 'WIO', 'NWC'),
        feature_group_count=B_WIDTH)
    return b_gate * y


def dsa_mixer(c_q_raw, c_kv_raw, k_idx_raw, w_idx_raw, q_norm_g, kv_norm_g,
              w_uq, w_uk, w_uv, idx_wq, idx_k_g, idx_k_b):
    bn, s, _ = c_q_raw.shape
    topk = min(C_MAX_TOPK, s // 4)
    nb = s // C_QBLOCK
    cq = rms_norm(c_q_raw, q_norm_g)
    ckv = rms_norm(c_kv_raw, kv_norm_g).astype(F32)
    q = (cq @ w_uq).reshape(bn, s, C_HEADS, C_HEAD_DIM)
    q_lat = jnp.einsum('bshd,hdc->bshc', q, w_uk).astype(F32) * (C_HEAD_DIM ** -0.5)
    q_idx = (cq @ idx_wq).reshape(bn, s, C_IDX_HEADS, C_IDX_DIM).astype(F32) * (C_IDX_DIM ** -0.5)
    k_idx = layer_norm(k_idx_raw, idx_k_g, idx_k_b).astype(F32)
    w_idx = w_idx_raw.astype(F32) * (C_IDX_HEADS ** -0.5)

    def blocks(t):
        return jnp.moveaxis(t.reshape((bn, nb, C_QBLOCK) + t.shape[2:]), 1, 0)

    starts = jnp.arange(nb, dtype=jnp.int32) * C_QBLOCK
    key_pos = jnp.arange(s, dtype=jnp.int32)

    def one_block(args):
        qb, qib, wb, start = args
        t_pos = start + jnp.arange(C_QBLOCK, dtype=jnp.int32)
        logits = jnp.einsum('bthd,bsd->bths', qib, k_idx)
        score = jnp.einsum('bths,bth->bts', jax.nn.relu(logits), wb)
        causal = key_pos[None, :] <= t_pos[:, None]
        score = jnp.where(causal[None], score, -jnp.inf)
        _, idx = lax.top_k(score, topk)
        valid = idx <= t_pos[None, :, None]
        kv_sel = jax.vmap(lambda c, i: c[i])(ckv, idx)
        sc = jnp.einsum('bthc,btkc->bthk', qb, kv_sel)
        sc = jnp.where(valid[:, :, None, :], sc, -jnp.inf)
        p = jax.nn.softmax(sc, axis=-1)
        return jnp.einsum('bthk,btkc->bthc', p, kv_sel)

    o_lat = lax.map(one_block, (blocks(q_lat), blocks(q_idx), blocks(w_idx), starts))
    o_lat = jnp.moveaxis(o_lat, 0, 1).reshape(bn, s, C_HEADS, C_KV_RANK)
    o = jnp.einsum('bshc,hcd->bshd', o_lat, w_uv.astype(F32))
    return o.reshape(bn, s, C_WIDTH)


def spatial_gating_mixer(u_raw, v_raw, v_g, v_b, w_s, b_s):
    bn, s, _ = u_raw.shape
    nch = s // D_CHUNK
    u = jax.nn.gelu(u_raw, approximate=False)
    v = layer_norm(jax.nn.gelu(v_raw, approximate=False), v_g, v_b)
    v = v.reshape(bn, nch, D_CHUNK, D_GROUPS, D_GROUP_DIM)
    w_causal = w_s * jnp.tril(jnp.ones((D_CHUNK, D_CHUNK), w_s.dtype))
    mixed = jnp.einsum('gts,bnsgc->bntgc', w_causal, v) + b_s.T[:, :, None]
    return u * mixed.reshape(bn, s, D_WIDTH)


def memory_cross_attention(h, mem, mem_g, wq, wkv, wo):
    bn, s, _ = h.shape
    m_len = mem.shape[1]
    m = rms_norm(mem, mem_g)
    q = (h @ wq).reshape(bn, s, X_HEADS, X_HEAD_DIM)
    kv = (m @ wkv).reshape(bn, m_len, 2, X_HEADS, X_HEAD_DIM)
    k, v = kv[:, :, 0], kv[:, :, 1]
    sc = jnp.einsum('bshd,bmhd->bhsm', q, k).astype(F32) * (X_HEAD_DIM ** -0.5)
    p = jax.nn.softmax(sc, axis=-1).astype(v.dtype)
    o = jnp.einsum('bhsm,bmhd->bshd', p, v).reshape(bn, s, D_MODEL)
    return o @ wo


def swiglu_ffn(h, w13, w2):
    gu = h @ w13
    g, u = gu[..., :FF_DIM], gu[..., FF_DIM:]
    return (jax.nn.silu(g) * u) @ w2


def setup_inputs(seed: int = 0) -> dict:
    key = jax.random.key(seed)
    ks = iter(jax.random.split(key, 64))

    def nrm(shape, fan_in):
        return jax.random.normal(next(ks), shape, F32) * (fan_in ** -0.5)

    def gain(shape):
        return 1.0 + 0.02 * jax.random.normal(next(ks), shape, F32)

    def small(shape, scale=0.02):
        return scale * jax.random.normal(next(ks), shape, F32)

    return {
        'x': jax.random.normal(next(ks), (BATCH, SEQ, D_MODEL), F32),
        'mem': jax.random.normal(next(ks), (BATCH, MEM_LEN, D_MODEL), F32),
        'hgrn_lower_bounds': small((DEPTH + 1, A_FDIM), 0.1),
        'even_mix_norm': gain((N_EVEN, D_MODEL)),
        'even_w_in': nrm((N_EVEN, D_MODEL, EVEN_IN), D_MODEL),
        'even_a_out_norm': gain((N_EVEN, A_HEADS, A_VDIM)),
        'even_b_conv': nrm((N_EVEN, B_CONV, B_WIDTH), B_CONV),
        'even_w_out': nrm((N_EVEN, A_WIDTH + B_WIDTH, D_MODEL), A_WIDTH + B_WIDTH),
        'odd_mix_norm': gain((N_ODD, D_MODEL)),
        'odd_w_in': nrm((N_ODD, D_MODEL, ODD_IN), D_MODEL),
        'odd_c_q_norm': gain((N_ODD, C_Q_RANK)),
        'odd_c_kv_norm': gain((N_ODD, C_KV_RANK)),
        'odd_c_w_uq': nrm((N_ODD, C_Q_RANK, C_HEADS * C_HEAD_DIM), C_Q_RANK),
        'odd_c_w_uk': nrm((N_ODD, C_HEADS, C_HEAD_DIM, C_KV_RANK), C_KV_RANK),
        'odd_c_w_uv': nrm((N_ODD, C_HEADS, C_KV_RANK, C_HEAD_DIM), C_KV_RANK),
        'odd_c_idx_wq': nrm((N_ODD, C_Q_RANK, C_IDX_HEADS * C_IDX_DIM), C_Q_RANK),
        'odd_c_idx_k_g': gain((N_ODD, C_IDX_DIM)),
        'odd_c_idx_k_b': small((N_ODD, C_IDX_DIM)),
        'odd_d_v_g': gain((N_ODD, D_WIDTH)),
        'odd_d_v_b': small((N_ODD, D_WIDTH)),
        'odd_d_w_s': nrm((N_ODD, D_GROUPS, D_CHUNK, D_CHUNK), D_CHUNK),
        'odd_d_b_s': gain((N_ODD, D_GROUPS, D_CHUNK)),
        'odd_w_out': nrm((N_ODD, C_WIDTH + D_WIDTH, D_MODEL), C_WIDTH + D_WIDTH),
        'xa_norm': gain((DEPTH, D_MODEL)),
        'xa_mem_norm': gain((DEPTH, D_MODEL)),
        'xa_wq': nrm((DEPTH, D_MODEL, D_MODEL), D_MODEL),
        'xa_wkv': nrm((DEPTH, D_MODEL, 2 * D_MODEL), D_MODEL),
        'xa_wo': nrm((DEPTH, D_MODEL, D_MODEL), D_MODEL),
        'ffn_norm': gain((DEPTH, D_MODEL)),
        'ffn_w13': nrm((DEPTH, D_MODEL, 2 * FF_DIM), D_MODEL),
        'ffn_w2': nrm((DEPTH, FF_DIM, D_MODEL), FF_DIM),
        'final_norm': gain((D_MODEL,)),
    }


def reference(x, mem, hgrn_lower_bounds, even_mix_norm, even_w_in, even_a_out_norm,
              even_b_conv, even_w_out, odd_mix_norm, odd_w_in, odd_c_q_norm, odd_c_kv_norm,
              odd_c_w_uq, odd_c_w_uk, odd_c_w_uv, odd_c_idx_wq, odd_c_idx_k_g, odd_c_idx_k_b,
              odd_d_v_g, odd_d_v_b, odd_d_w_s, odd_d_b_s, odd_w_out, xa_norm, xa_mem_norm,
              xa_wq, xa_wkv, xa_wo, ffn_norm, ffn_w13, ffn_w2, final_norm):
    lower_bounds = jnp.cumsum(jax.nn.softmax(hgrn_lower_bounds.astype(F32), axis=0), axis=0)
    for layer in range(DEPTH):
        j = layer // 2
        if layer % 2 == 0:
            h = rms_norm(x, even_mix_norm[j])
            proj = h @ even_w_in[j]
            aq, af, ai, ag, bb, bc, bh = split_cols(proj, EVEN_SPLITS)
            o_a = hgrn2_mixer(aq, af, ai, ag, lower_bounds[layer], even_a_out_norm[j])
            o_b = short_conv_mixer(bb, bc, bh, even_b_conv[j])
            mixed = jnp.concatenate([o_a.astype(x.dtype), o_b.astype(x.dtype)], axis=-1) @ even_w_out[j]
        else:
            h = rms_norm(x, odd_mix_norm[j])
            proj = h @ odd_w_in[j]
            cq, ckv, kidx, widx, du, dv = split_cols(proj, ODD_SPLITS)
            o_c = dsa_mixer(cq, ckv, kidx, widx, odd_c_q_norm[j], odd_c_kv_norm[j],
                            odd_c_w_uq[j], odd_c_w_uk[j], odd_c_w_uv[j], odd_c_idx_wq[j],
                            odd_c_idx_k_g[j], odd_c_idx_k_b[j])
            o_d = spatial_gating_mixer(du, dv, odd_d_v_g[j], odd_d_v_b[j], odd_d_w_s[j], odd_d_b_s[j])
            mixed = jnp.concatenate([o_c.astype(x.dtype), o_d.astype(x.dtype)], axis=-1) @ odd_w_out[j]
        x = x + mixed.astype(x.dtype)
        x = x + memory_cross_attention(rms_norm(x, xa_norm[layer]), mem, xa_mem_norm[layer],
                                       xa_wq[layer], xa_wkv[layer], xa_wo[layer]).astype(x.dtype)
        x = x + swiglu_ffn(rms_norm(x, ffn_norm[layer]), ffn_w13[layer], ffn_w2[layer]).astype(x.dtype)
    return rms_norm(x, final_norm)
```

```cpp
#include <hip/hip_runtime.h>
#include <cstdio>
#include <cstdint>

#ifndef MK_N_LAUNCHES
#define MK_N_LAUNCHES 1
#endif

#ifndef LAUNCH_MASK
#define LAUNCH_MASK 0x7fffffu
#define TRUNC_SLOT 6
#define DBG_A0SRC 0
#define DBG_FIN_SRC WS_HO
#define HG_DBG 0
#endif
#ifndef DSA_DUP
#define DSA_DUP 0
#endif
#define LAS __attribute__((address_space(3)))
#define GAS __attribute__((address_space(1)))
typedef unsigned short bf16_t;
typedef short bf16x8 __attribute__((ext_vector_type(8)));
typedef short s16x4 __attribute__((ext_vector_type(4)));
typedef float f32x4 __attribute__((ext_vector_type(4)));
typedef float f32x2 __attribute__((ext_vector_type(2)));
typedef float f32x16 __attribute__((ext_vector_type(16)));
typedef unsigned u32x4 __attribute__((ext_vector_type(4)));
typedef unsigned u32x2 __attribute__((ext_vector_type(2)));
typedef GAS unsigned gu32;

constexpr int BATCH = 8, SEQ = 8192, D = 1024, M = BATCH * SEQ;
constexpr int MEMLEN = 256, MROWS = BATCH * MEMLEN;
constexpr int FF = 2816;
constexpr int NIN0 = 3584, NIN1 = 1536;
constexpr int NWAVES = 8, NTHR = 512;

constexpr size_t MiB = 1u << 20;
constexpr size_t WS_CTL = 0, CTL_ZERO_BYTES = 1 * MiB;
constexpr size_t WS_W_IN0T  = 2 * MiB;
constexpr size_t WS_W_OUT0T = WS_W_IN0T + (size_t)NIN0 * D * 2;
constexpr size_t WS_W_IN1T  = WS_W_OUT0T + (size_t)D * D * 2;
constexpr size_t WS_W_Q1T   = WS_W_IN1T + (size_t)NIN1 * D * 2;
constexpr size_t WS_W_OUT1T = WS_W_Q1T + (size_t)1536 * 256 * 2;
constexpr size_t WS_W_XQT   = WS_W_OUT1T + (size_t)D * 1536 * 2;
constexpr size_t WS_W_XKT   = WS_W_XQT + (size_t)2 * D * D * 2;
constexpr size_t WS_W_XVT   = WS_W_XKT + (size_t)2048 * D * 2;
constexpr size_t WS_W_XOT   = WS_W_XVT + (size_t)2048 * D * 2;
constexpr size_t WS_W_13T   = WS_W_XOT + (size_t)2 * D * D * 2;
constexpr size_t WS_W_2T    = WS_W_13T + (size_t)2 * 5632 * D * 2;
constexpr size_t WS_WC      = WS_W_2T + (size_t)2 * D * FF * 2;
constexpr size_t WS_LB      = WS_WC + (size_t)4 * 128 * 128 * 2;
constexpr size_t WS_MEMB    = WS_LB + 4096;
constexpr size_t WS_MEMRS   = WS_MEMB + (size_t)MROWS * D * 2;
constexpr size_t WS_KM      = WS_MEMRS + (size_t)MROWS * 4;
constexpr size_t WS_VT      = WS_KM + (size_t)MROWS * 2048 * 2;
constexpr size_t WS_RSP     = WS_VT + (size_t)2048 * MROWS * 2;
constexpr size_t WS_EBG     = WS_RSP + (size_t)7 * M * 16;
constexpr size_t WS_DVST    = WS_EBG + (size_t)(M / 64) * 512 * 4;
constexpr size_t WS_WIDX    = WS_DVST + (size_t)M * 16;
constexpr size_t WS_SLOC    = WS_WIDX + (size_t)M * 32;
constexpr size_t WS_DSEG    = WS_SLOC + (size_t)256 * 16384 * 4;
constexpr size_t WS_XB      = 124 * MiB;
constexpr size_t WS_BIG1    = 252 * MiB;
constexpr size_t WS_BIG2    = 636 * MiB;
constexpr size_t WS_WQK     = 988 * MiB;
constexpr size_t WS_VWOT    = 1004 * MiB;
constexpr size_t WS_END     = 1020 * MiB;
static_assert(WS_BIG2 + (size_t)M * FF * 2 <= WS_WQK, "ws map");
static_assert(WS_DSEG + (size_t)256 * 128 * 4 <= WS_XB, "ws map");
constexpr size_t T64 = (size_t)M * 512 * 2;
constexpr size_t WS_QE = WS_BIG1, WS_KINV = WS_BIG1 + T64, WS_KDEC = WS_BIG1 + 2 * T64, WS_HV = WS_BIG1 + 3 * T64, WS_HZ = WS_BIG1 + 4 * T64;
constexpr size_t WS_A0 = WS_BIG2, WS_HO = WS_BIG2 + 2 * T64, WS_HG = WS_BIG2 + 3 * T64, WS_HB = WS_BIG2 + 4 * T64;
constexpr size_t WS_P = WS_BIG1, WS_ACT = WS_BIG2;
constexpr size_t WS_CQN = WS_BIG1, WS_CKVN = WS_CQN + (size_t)M * 256 * 2, WS_KIDXN = WS_CKVN + (size_t)M * 128 * 2, WS_U = WS_KIDXN + (size_t)M * 64 * 2,
                 WS_DV = WS_U + T64, WS_QL = WS_DV + T64, WS_QI = WS_QL + 2 * T64, WS_A1 = WS_BIG2, WS_P1RAW = WS_BIG2;
static_assert(WS_QI + T64 <= WS_BIG2, "ws map");
constexpr size_t WS_SCR = WS_BIG2 + 192 * MiB;
static_assert(WS_SCR + (size_t)256 * 524288 <= WS_BIG2 + 384 * MiB, "ws map");

constexpr int CW_TMO = 0;
constexpr int CW_BAR = 4096;

constexpr int RING_BYTES = 131072;
constexpr int XLDS_OFF = RING_BYTES;
constexpr int MISC_OFF = 159744 - 256;
constexpr int PTAB_OFF = 159744 - 512;
constexpr int LDS_BYTES = 159744;

#define RLX_AGENT __ATOMIC_RELAXED, __HIP_MEMORY_SCOPE_AGENT
#define LDS_WAIT() asm volatile("s_waitcnt lgkmcnt(0)" ::: "memory")
#define VM_WAIT() asm volatile("s_waitcnt vmcnt(0)" ::: "memory")
#define WG_BAR() do { asm volatile("s_waitcnt vmcnt(0) lgkmcnt(0)" ::: "memory"); __builtin_amdgcn_s_barrier(); asm volatile("" ::: "memory"); } while (0)
#define LDS_BAR() do { asm volatile("s_waitcnt lgkmcnt(0)" ::: "memory"); __builtin_amdgcn_s_barrier(); asm volatile("" ::: "memory"); } while (0)

typedef __bf16 bf16x2_t __attribute__((ext_vector_type(2)));
__device__ __forceinline__ unsigned cvt_pk_bf16(float lo, float hi) { const f32x2 v = {lo, hi}; return __builtin_bit_cast(unsigned, __builtin_convertvector(v, bf16x2_t)); }
__device__ __forceinline__ u32x2 pack4(f32x4 v) { u32x2 w; w.x = cvt_pk_bf16(v[0], v[1]); w.y = cvt_pk_bf16(v[2], v[3]); return w; }
__device__ __forceinline__ u32x4 pack8(f32x4 a, f32x4 b) { u32x4 w; w.x = cvt_pk_bf16(a[0], a[1]); w.y = cvt_pk_bf16(a[2], a[3]); w.z = cvt_pk_bf16(b[0], b[1]); w.w = cvt_pk_bf16(b[2], b[3]); return w; }
__device__ __forceinline__ float bf2f(unsigned short b) { return __uint_as_float(((unsigned)b) << 16); }
__device__ __forceinline__ float bflo(unsigned w) { return __uint_as_float(w << 16); }
__device__ __forceinline__ float bfhi(unsigned w) { return __uint_as_float(w & 0xffff0000u); }
__device__ __forceinline__ float fast_exp2(float x) { return __builtin_amdgcn_exp2f(x); }
__device__ __forceinline__ float fast_rcp(float x) { return __builtin_amdgcn_rcpf(x); }
__device__ __forceinline__ float fast_rsq(float x) { return __builtin_amdgcn_rsqf(x); }
__device__ __forceinline__ float sigmoid_f(float x) { return fast_rcp(1.0f + fast_exp2(-1.4426950408889634f * x)); }
__device__ __forceinline__ float silu_f(float x) { return x * sigmoid_f(x); }
__device__ __forceinline__ float gelu_f(float v) {
    const float av = __builtin_fabsf(v), t = fast_rcp(av * 0.2316418882f + 1.0f);
    float q = t * 0.5307027145f + (-0.7265760135f); q = q * t + 0.7107068705f; q = q * t + (-0.142248368f); q = q * t + 0.127414796f; q = q * t;
    const float e = fast_exp2((v * v) * (-0.72134752044f));
    const float m = v * (q * e);
    return v < 0.f ? m : v - m;
}
__device__ __forceinline__ int opq(int v) { asm volatile("" : "+v"(v)); return v; }
__device__ __forceinline__ int opq_s(int v) { asm volatile("" : "+s"(v)); return v; }
__device__ __forceinline__ float wave_sum(float v) {
    v += __builtin_bit_cast(float, __builtin_amdgcn_update_dpp(0, __builtin_bit_cast(int, v), 0x111, 0xf, 0xf, true));
    v += __builtin_bit_cast(float, __builtin_amdgcn_update_dpp(0, __builtin_bit_cast(int, v), 0x112, 0xf, 0xf, true));
    v += __builtin_bit_cast(float, __builtin_amdgcn_update_dpp(0, __builtin_bit_cast(int, v), 0x114, 0xf, 0xf, true));
    v += __builtin_bit_cast(float, __builtin_amdgcn_update_dpp(0, __builtin_bit_cast(int, v), 0x118, 0xf, 0xf, true));
    v += __builtin_bit_cast(float, __builtin_amdgcn_update_dpp(0, __builtin_bit_cast(int, v), 0x142, 0xa, 0xf, false));
    v += __builtin_bit_cast(float, __builtin_amdgcn_update_dpp(0, __builtin_bit_cast(int, v), 0x143, 0xc, 0xf, false));
    return __builtin_bit_cast(float, __builtin_amdgcn_readlane(__builtin_bit_cast(int, v), 63));
}

#define XB_TMO      128
#define XB_XCNT(j)  (256  + 64 * (j))
#define XB_XSUB(j)  (1280 + 64 * (j))
#define XB_XGEN(j)  (2304 + 64 * (j))
#define XB_TOP      3328
#define XB_TOPGEN   3392
#define XCD_BAR_WORDS 3456
#define XB_SPIN_CAP (1u << 22)

__device__ __forceinline__ unsigned xb_ld(unsigned* p)              { return __hip_atomic_load(p, __ATOMIC_RELAXED, __HIP_MEMORY_SCOPE_AGENT); }
__device__ __forceinline__ unsigned xb_add(unsigned* p, unsigned v) { return __hip_atomic_fetch_add(p, v, __ATOMIC_RELAXED, __HIP_MEMORY_SCOPE_AGENT); }
__device__ __forceinline__ unsigned xb_xcc_id() { return (unsigned)__builtin_amdgcn_s_getreg((3 << 11) | 20) & 0xFu; }
#define XB_SPIN(cond, bar) do { unsigned _sp = 0; while (cond) { __builtin_amdgcn_s_sleep(1); \
    if ((++_sp & 255u) == 0u) { if (xb_ld(&(bar)[XB_TMO])) break; if (_sp > XB_SPIN_CAP) { atomicAdd(&(bar)[XB_TMO], 1u); break; } } } } while (0)

struct XcdBarrier { unsigned* bar; unsigned x; volatile LAS unsigned* st; };
__device__ __forceinline__ XcdBarrier xcd_barrier_post(unsigned* bar, volatile LAS unsigned* st) {
    XcdBarrier b; b.bar = bar; b.x = xb_xcc_id(); b.st = st;
    if (threadIdx.x == 0) (void)xb_add(&bar[XB_XCNT(b.x)], 1u);
    return b;
}
__device__ __forceinline__ void xcd_barrier_complete(unsigned* bar, unsigned x, unsigned& nloc, unsigned& nx) {
    const unsigned G = gridDim.x * gridDim.y * gridDim.z;
    unsigned sum, cnt, mine, sp = 0u;
    for (;;) {
        sum = 0u; cnt = 0u; mine = 0u;
#pragma unroll
        for (unsigned j = 0; j < 16; ++j) { const unsigned c = xb_ld(&bar[XB_XCNT(j)]); sum += c; cnt += (c > 0u) ? 1u : 0u; mine = (j == x) ? c : mine; }
        if (sum == G) break;
        __builtin_amdgcn_s_sleep(1);
        if ((++sp & 255u) == 0u) { if (xb_ld(&bar[XB_TMO])) break; if (sp > XB_SPIN_CAP) { atomicAdd(&bar[XB_TMO], 1u); break; } }
    }
    nloc = mine > 0u ? mine : 1u; nx = cnt > 0u ? cnt : 1u;
}
__device__ __forceinline__ void xcd_barrier(const XcdBarrier& b) {
    asm volatile("s_waitcnt vmcnt(0)" ::: "memory");
    __syncthreads();
    if (threadIdx.x == 0) {
        unsigned* bar = b.bar;
        __builtin_amdgcn_s_waitcnt(0);
        unsigned nloc = b.st[0], nx = b.st[1];
        if (nloc == 0u) { xcd_barrier_complete(bar, b.x, nloc, nx); b.st[0] = nloc; b.st[1] = nx; }
        const unsigned old = xb_add(&bar[XB_XSUB(b.x)], 1u);
        const unsigned gen = old / nloc;
        if (old + 1u == (gen + 1u) * nloc) {
            __builtin_amdgcn_fence(__ATOMIC_RELEASE, "agent");
            asm volatile("s_waitcnt vmcnt(0)" ::: "memory");
            const unsigned og = xb_add(&bar[XB_TOP], 1u);
            const unsigned tg = og / nx;
            if (og + 1u == (tg + 1u) * nx) xb_add(&bar[XB_TOPGEN], 1u);
            else XB_SPIN(xb_ld(&bar[XB_TOPGEN]) == tg, bar);
            __builtin_amdgcn_fence(__ATOMIC_ACQUIRE, "agent");
            xb_add(&bar[XB_XGEN(b.x)], 1u);
            asm volatile("s_waitcnt vmcnt(0)" ::: "memory");
        } else {
            XB_SPIN(xb_ld(&bar[XB_XGEN(b.x)]) == gen, bar);
            __builtin_amdgcn_fence(__ATOMIC_ACQUIRE, "agent");
            asm volatile("s_waitcnt vmcnt(0)" ::: "memory");
        }
    }
    __syncthreads();
}

namespace pg8 {
constexpr int BM = 256, BK = 64, HALF = 128, HTB = HALF * BK * 2, NXCD = 8, WGM = 8;
__host__ __device__ __forceinline__ int lds_byte(int r, int c) { const int st = (r >> 4) * 2 + (c >> 5), rr = r & 15, cc = c & 31, ob = rr * 64 + cc * 2; return st * 1024 + (ob ^ (((ob >> 9) & 1) << 5)); }
__host__ __device__ __forceinline__ void stage_rc(int b, int& R, int& C) { const int st = b / 1024, sb = b % 1024, swz = sb ^ (((sb >> 9) & 1) << 5); R = (st >> 1) * 16 + swz / 64; C = (st & 1) * 32 + (swz % 64) / 2; }
__host__ __device__ __forceinline__ int perm32(int rho) { const int n = rho >> 4, i = rho & 15; return 8 * (i >> 2) + 4 * n + (i & 3); }
struct Unit { int pm, pn; };
struct Gemm { const bf16_t* A; const bf16_t* Bt; int lda, ldb, K; size_t a_pm, a_pn, b_pn, b_pm; int b_sh; };
__device__ __forceinline__ Gemm plain_gemm(const bf16_t* A, const bf16_t* Bt, int K) { Gemm g; g.A = A; g.Bt = Bt; g.lda = K; g.ldb = K; g.K = K; g.a_pm = (size_t)256 * K * 2; g.a_pn = 0; g.b_pn = (size_t)256 * K * 2; g.b_pm = 0; g.b_sh = 0; return g; }
struct StaticOrder {
    int nM, nN, nwg, G, c;
    __device__ void init(int nM_, int nN_, int G_, int c_) { nM = nM_; nN = nN_; nwg = nM * nN; G = G_; c = c_; }
    __device__ void init_panel(int nN_, int pm_) { nM = 1; nN = nN_; nwg = nN_; G = -1; c = pm_; }
    __device__ bool next(int i, Unit& u) const {
        if (G < 0) { if (i >= nN) return false; u.pm = c; u.pn = (i + (c >> 3)) % nN; return true; }
        const long L = (long)i * G + c; if (L >= nwg) return false;
        int wgid = (int)L; { const int q = nwg / NXCD, r = nwg % NXCD, xcd = wgid % NXCD, off = wgid / NXCD; wgid = (xcd < r ? xcd * (q + 1) : r * (q + 1) + (xcd - r) * q) + off; }
        const int nig = WGM * nN, gid = wgid / nig, fm = gid * WGM, gsz = (nM - fm) < WGM ? (nM - fm) : WGM;
        u.pm = fm + ((wgid % nig) % gsz); u.pn = (wgid % nig) / gsz; return true;
    }
};
struct EpiCtx { int wr, wc, fr, fq, wid, lane; LAS unsigned char* xl; };

template <class Epi>
__device__ __forceinline__ void gemm_phase(LAS unsigned char* lds, const Gemm g, const StaticOrder& S, const Epi& E) {
    int tid_ = threadIdx.x; asm volatile("" : "+v"(tid_));
    const int tid = tid_, wid = __builtin_amdgcn_readfirstlane(tid >> 6), lane = tid & 63, wr = wid >> 2, wc = wid & 3, fr = lane & 15, fq = lane >> 4;
    const int K = g.K, nt = K / BK;
    unsigned voffA[2], voffB[2];
#pragma unroll
    for (int i = 0; i < 2; ++i) { int R, C; stage_rc(tid * 16 + i * 8192, R, C); const int Rb = Epi::PERM ? ((R & ~31) + perm32(R & 31)) : R;
        voffA[i] = (unsigned)(R * g.lda + C) * 2u; voffB[i] = (unsigned)(Rb * g.ldb + C) * 2u; }
    const size_t kstep = (size_t)(BK * 2);
    const size_t hstepA = (size_t)HALF * g.lda * 2, hstepB = (size_t)HALF * g.ldb * 2;
    const unsigned ldsw = (unsigned)wid * 1024u;
    const int aoff = lds_byte(wr * 64 + fr, fq * 8), boff = lds_byte(wc * 32 + fr, fq * 8);
    EpiCtx cx; cx.wr = wr; cx.wc = wc; cx.fr = fr; cx.fq = fq; cx.wid = wid; cx.lane = lane; cx.xl = lds + XLDS_OFF;
#define PG8_SA(b, h) (((b) * 2 + (h)) * HTB)
#define PG8_SB(b, h) ((4 + (b) * 2 + (h)) * HTB)
#define PG8_STAGE(bufoff, gbase, voff) do { _Pragma("unroll") for (int _i = 0; _i < 2; ++_i) \
        __builtin_amdgcn_global_load_lds((const unsigned*)((const char*)(gbase) + (voff)[_i]), (LAS unsigned*)(lds + (bufoff) + ldsw + _i * 8192), 16, 0, 0); } while (0)
#define PG8_LDA(dst, b, h) do { _Pragma("unroll") for (int m = 0; m < 4; ++m) _Pragma("unroll") for (int k = 0; k < 2; ++k) dst[m][k] = *(const LAS bf16x8*)(lds + PG8_SA(b, h) + aoff + m * 2048 + k * 1024); } while (0)
#define PG8_LDB(dst, b, h) do { _Pragma("unroll") for (int n = 0; n < 2; ++n) _Pragma("unroll") for (int k = 0; k < 2; ++k) dst[n][k] = *(const LAS bf16x8*)(lds + PG8_SB(b, h) + boff + n * 2048 + k * 1024); } while (0)
#define PG8_MMA(ai, bj, At, Bt) do { __builtin_amdgcn_s_setprio(1); _Pragma("unroll") for (int m = 0; m < 4; ++m) _Pragma("unroll") for (int n = 0; n < 2; ++n) _Pragma("unroll") for (int k = 0; k < 2; ++k) \
        acc[ai][bj][m][n] = __builtin_amdgcn_mfma_f32_16x16x32_bf16(Bt[n][k], At[m][k], acc[ai][bj][m][n], 0, 0, 0); __builtin_amdgcn_s_setprio(0); } while (0)
#define PG8_WAIT_V(n) asm volatile("s_waitcnt vmcnt(" #n ")" ::: "memory")
#define PG8_WAIT_L(n) asm volatile("s_waitcnt lgkmcnt(" #n ")" ::: "memory")
#define PG8_BAR __builtin_amdgcn_s_barrier()
#define PG8_SCHED __builtin_amdgcn_sched_barrier(0)
    Unit cur, nxt; int ui = 0;
    if (!S.next(0, cur)) return;
    f32x4 acc[2][2][4][2];
#pragma unroll
    for (int a = 0; a < 2; ++a)
#pragma unroll
        for (int b = 0; b < 2; ++b)
#pragma unroll
            for (int m = 0; m < 4; ++m)
#pragma unroll
                for (int n = 0; n < 2; ++n) acc[a][b][m][n] = (f32x4){0.f, 0.f, 0.f, 0.f};
    bf16x8 At[4][2], B0[2][2], B1[2][2];
    const char* cA = (const char*)g.A + (size_t)cur.pm * g.a_pm + (size_t)cur.pn * g.a_pn;
    const char* cB = (const char*)g.Bt + (size_t)cur.pn * g.b_pn + (size_t)(cur.pm >> g.b_sh) * g.b_pm;
    PG8_STAGE(PG8_SB(0, 0), cB, voffB); PG8_STAGE(PG8_SB(0, 1), cB + hstepB, voffB); PG8_STAGE(PG8_SA(0, 0), cA, voffA); PG8_STAGE(PG8_SA(0, 1), cA + hstepA, voffA);
    if (wr == 1) PG8_BAR;
    PG8_WAIT_V(2); PG8_BAR;
    PG8_STAGE(PG8_SB(1, 0), cB + kstep, voffB); PG8_STAGE(PG8_SA(1, 0), cA + kstep, voffA); PG8_STAGE(PG8_SB(1, 1), cB + hstepB + kstep, voffB);
    PG8_WAIT_V(6); PG8_BAR;
    for (;;) {
        if constexpr (Epi::RSPRE) {
            if (wid < 4) __builtin_amdgcn_global_load_lds((const unsigned*)((const char*)E.rs_src() + (size_t)cur.pm * 4096 + (unsigned)(tid << 4)), (LAS unsigned*)(lds + XLDS_OFF + 12288 + wid * 1024), 16, 0, 0); }
        const bool has_next = S.next(ui + 1, nxt);
        const char* nA = has_next ? (const char*)g.A + (size_t)nxt.pm * g.a_pm + (size_t)nxt.pn * g.a_pn : cA;
        const char* nB = has_next ? (const char*)g.Bt + (size_t)nxt.pn * g.b_pn + (size_t)(nxt.pm >> g.b_sh) * g.b_pm : cB;
        for (int t = 0; t < nt; t += 2) {
            const bool last = (t == nt - 2);
            const char* a1 = cA + (size_t)(t + 1) * kstep;
            const char* a2 = last ? nA : cA + (size_t)(t + 2) * kstep; const char* b2 = last ? nB : cB + (size_t)(t + 2) * kstep;
            const char* a3 = a2 + kstep; const char* b3 = b2 + kstep;
            PG8_LDB(B0, 0, 0); PG8_LDB(B1, 0, 1); PG8_SCHED; PG8_LDA(At, 0, 0); PG8_STAGE(PG8_SA(1, 1), a1 + hstepA, voffA);
            PG8_WAIT_V(8); PG8_WAIT_L(0); PG8_BAR; PG8_MMA(0, 0, At, B0); PG8_MMA(0, 1, At, B1); PG8_BAR; PG8_SCHED;
            PG8_LDA(At, 0, 1); PG8_STAGE(PG8_SB(0, 0), b2, voffB); PG8_STAGE(PG8_SB(0, 1), b2 + hstepB, voffB); PG8_STAGE(PG8_SA(0, 0), a2, voffA);
            PG8_WAIT_V(8); PG8_WAIT_L(0); PG8_BAR; PG8_MMA(1, 0, At, B0); PG8_MMA(1, 1, At, B1); PG8_BAR; PG8_SCHED;
            PG8_LDB(B0, 1, 0); PG8_LDB(B1, 1, 1); PG8_SCHED; PG8_LDA(At, 1, 0); PG8_STAGE(PG8_SA(0, 1), a2 + hstepA, voffA);
            PG8_WAIT_V(8); PG8_WAIT_L(0); PG8_BAR; PG8_MMA(0, 0, At, B0); PG8_MMA(0, 1, At, B1); PG8_BAR; PG8_SCHED;
            PG8_LDA(At, 1, 1); PG8_STAGE(PG8_SB(1, 0), b3, voffB); PG8_STAGE(PG8_SB(1, 1), b3 + hstepB, voffB); PG8_STAGE(PG8_SA(1, 0), a3, voffA);
            PG8_WAIT_V(8); PG8_WAIT_L(0); PG8_BAR; PG8_MMA(1, 0, At, B0); PG8_MMA(1, 1, At, B1); PG8_BAR; PG8_SCHED;
        }
        if (wr == 0) PG8_BAR;
        { EpiCtx cy = cx; asm volatile("" : "+v"(cy.fr), "+v"(cy.fq), "+v"(cy.lane));
          E(acc, cur, cy); }
        if (!has_next) break;
#pragma unroll
        for (int a = 0; a < 2; ++a)
#pragma unroll
            for (int b = 0; b < 2; ++b)
#pragma unroll
                for (int m = 0; m < 4; ++m)
#pragma unroll
                    for (int n = 0; n < 2; ++n) acc[a][b][m][n] = (f32x4){0.f, 0.f, 0.f, 0.f};
        cur = nxt; cA = nA; cB = nB; ++ui;
        if (wr == 1) PG8_BAR;
    }
    PG8_WAIT_V(0);
    PG8_BAR;
#undef PG8_SA
#undef PG8_SB
#undef PG8_STAGE
#undef PG8_LDA
#undef PG8_LDB
#undef PG8_MMA
#undef PG8_WAIT_V
#undef PG8_WAIT_L
#undef PG8_BAR
#undef PG8_SCHED
}
}
using pg8::Unit; using pg8::EpiCtx;
typedef f32x4 (&AccRef)[2][2][4][2];

__device__ __forceinline__ void load_rs(const float* rsp, const Unit& u, const EpiCtx& cx, float inv_n, float eps, float (&rs)[2][4]) {
#pragma unroll
    for (int ai = 0; ai < 2; ++ai)
#pragma unroll
        for (int m = 0; m < 4; ++m) { const int row = u.pm * 256 + ai * 128 + cx.wr * 64 + m * 16 + cx.fr; const f32x4 p = *(const f32x4*)(rsp + (size_t)row * 4);
            rs[ai][m] = fast_rsq(((p[0] + p[1]) + (p[2] + p[3])) * inv_n + eps); }
}
__device__ __forceinline__ void load_rs_lds(const EpiCtx& cx, float inv_n, float eps, float (&rs)[2][4]) {
#pragma unroll
    for (int ai = 0; ai < 2; ++ai)
#pragma unroll
        for (int m = 0; m < 4; ++m) { const int rl = ai * 128 + cx.wr * 64 + m * 16 + cx.fr; const f32x4 p = *(const LAS f32x4*)(cx.xl + 12288 + rl * 16);
            rs[ai][m] = fast_rsq(((p[0] + p[1]) + (p[2] + p[3])) * inv_n + eps); }
}
__device__ __forceinline__ void row_swap16(float v, float& a, float& b) { const unsigned u = __builtin_bit_cast(unsigned, v); const auto r = __builtin_amdgcn_permlane16_swap(u, u, false, false);
    const unsigned r0 = r[0], r1 = r[1]; a = __builtin_bit_cast(float, r0); b = __builtin_bit_cast(float, r1); }
__device__ __forceinline__ void row_swap32(float v, float& a, float& b) { const unsigned u = __builtin_bit_cast(unsigned, v); const auto r = __builtin_amdgcn_permlane32_swap(u, u, false, false);
    const unsigned r0 = r[0], r1 = r[1]; a = __builtin_bit_cast(float, r0); b = __builtin_bit_cast(float, r1); }
__device__ __forceinline__ float red_fq(float v) { float a, b; row_swap16(v, a, b); v = a + b; row_swap32(v, a, b); return a + b; }
__device__ __forceinline__ float max_fq(float v) { float a, b; row_swap16(v, a, b); v = fmaxf(a, b); row_swap32(v, a, b); return fmaxf(a, b); }

enum InIdx { I_X = 0, I_MEM, I_HLB, I_EMN, I_EWIN, I_EAON, I_EBCONV, I_EWOUT, I_OMN, I_OWIN, I_OCQN, I_OCKVN, I_OWUQ, I_OWUK, I_OWUV, I_OIDXWQ, I_OIDXKG, I_OIDXKB,
             I_ODVG, I_ODVB, I_ODWS, I_ODBS, I_OWOUT, I_XAN, I_XAMN, I_XAWQ, I_XAWKV, I_XAWO, I_FFN, I_FFW13, I_FFW2, I_FINAL, N_IN };
struct Args { const float* in[32]; float* out; unsigned char* ws; int ph_lo, ph_hi, fin_slot, pad; };
struct Frame { LAS unsigned char* lds; int tid, lane, wave, G, gw, NGW; };
#define INP(i) (*(const float* const LAS*)(F.lds + PTAB_OFF + 8 * (i)))

__device__ __forceinline__ void tr_item(const float* W, int ldw, int k0, int s0, int nvalid, bf16_t* WT, int ldwt, int n0, int kout0, const float* gain, float scale, LAS float* scr, int lane) {
    const int j = lane & 31;
#pragma unroll 8
    for (int i = 0; i < 32; ++i) { const int kk = 2 * i + (lane >> 5); float v = (j < nvalid) ? W[(size_t)(k0 + kk) * ldw + s0 + j] : 0.f; if (gain) v *= gain[k0 + kk]; scr[kk * 33 + j] = v * scale; }
    LDS_WAIT(); asm volatile("" ::: "memory");
    const int c = lane & 7;
#pragma unroll
    for (int jj = 0; jj < 4; ++jj) { const int n = (lane >> 3) + 8 * jj; const LAS float* s = scr + (8 * c) * 33 + n;
        u32x4 o; o.x = cvt_pk_bf16(s[0 * 33], s[1 * 33]); o.y = cvt_pk_bf16(s[2 * 33], s[3 * 33]); o.z = cvt_pk_bf16(s[4 * 33], s[5 * 33]); o.w = cvt_pk_bf16(s[6 * 33], s[7 * 33]);
        *(u32x4*)(WT + (size_t)(n0 + n) * ldwt + kout0 + k0 + 8 * c) = o; }
    LDS_WAIT(); asm volatile("" ::: "memory");
}
__device__ __forceinline__ int in0_src_col(int n) { const int pn = n >> 8, j = n & 255;
    if (pn < 4) return j < 128 ? pn * 128 + j : 512 + pn * 128 + (j - 128);
    if (pn < 10) return 1024 + (pn - 4) * 256 + j;
    const int q = pn - 10; return j < 128 ? 2560 + q * 128 + j : 3072 + q * 128 + (j - 128); }

__device__ __forceinline__ void p0_prologue(const Frame& F, unsigned char* ws) {
    LAS float* scr = (LAS float*)(F.lds + F.wave * 16384);
    constexpr int NJ = 17;
    const int jitems[NJ] = {1792, 512, 768, 64, 256, 0, 0, 512, 512, 512, 512, 512, 512, 2816, 2816, 1408, 1408};
    int total = 0;
#pragma unroll
    for (int j = 0; j < NJ; ++j) total += jitems[j];
    for (int it = F.gw; it < total; it += F.NGW) {
        int r = it, job = 0;
#pragma unroll
        for (int j = 0; j < NJ - 1; ++j) { if (job == j && r >= jitems[j]) { r -= jitems[j]; job = j + 1; } }
        const float* W; int ldw, K, Nout, ldwt, kout0 = 0; bf16_t* WT; const float* gain = nullptr; float scale = 1.f;
        switch (job) {
        case 0: W = INP(I_EWIN); ldw = NIN0; K = 1024; Nout = NIN0; WT = (bf16_t*)(ws + WS_W_IN0T); ldwt = 1024; gain = INP(I_EMN); break;
        case 1: W = INP(I_EWOUT); ldw = 1024; K = 1024; Nout = 1024; WT = (bf16_t*)(ws + WS_W_OUT0T); ldwt = 1024; break;
        case 2: W = INP(I_OWIN); ldw = 1480; K = 1024; Nout = 1536; WT = (bf16_t*)(ws + WS_W_IN1T); ldwt = 1024; gain = INP(I_OMN); break;
        case 3: W = INP(I_OIDXWQ); ldw = 512; K = 256; Nout = 512; WT = (bf16_t*)(ws + WS_W_Q1T) + (size_t)1024 * 256; ldwt = 256; gain = INP(I_OCQN); scale = 0.125f; break;
        case 4: W = INP(I_OWOUT) + (size_t)512 * 1024; ldw = 1024; K = 512; Nout = 1024; WT = (bf16_t*)(ws + WS_W_OUT1T); ldwt = 1536; kout0 = 1024; break;
        case 5: case 6: { const int L = job - 5; W = INP(I_XAWQ) + (size_t)L * D * D; ldw = 1024; K = 1024; Nout = 1024; WT = (bf16_t*)(ws + WS_W_XQT) + (size_t)L * D * D; ldwt = 1024; gain = INP(I_XAN) + L * D; } break;
        case 7: case 8: { const int L = job - 7; W = INP(I_XAWKV) + (size_t)L * D * 2048; ldw = 2048; K = 1024; Nout = 1024; WT = (bf16_t*)(ws + WS_W_XKT) + (size_t)L * D * D; ldwt = 1024; gain = INP(I_XAMN) + L * D; } break;
        case 9: case 10: { const int L = job - 9; W = INP(I_XAWKV) + (size_t)L * D * 2048 + 1024; ldw = 2048; K = 1024; Nout = 1024; WT = (bf16_t*)(ws + WS_W_XVT) + (size_t)L * D * D; ldwt = 1024; gain = INP(I_XAMN) + L * D; } break;
        case 11: case 12: { const int L = job - 11; W = INP(I_XAWO) + (size_t)L * D * D; ldw = 1024; K = 1024; Nout = 1024; WT = (bf16_t*)(ws + WS_W_XOT) + (size_t)L * D * D; ldwt = 1024; } break;
        case 13: case 14: { const int L = job - 13; W = INP(I_FFW13) + (size_t)L * D * 5632; ldw = 5632; K = 1024; Nout = 5632; WT = (bf16_t*)(ws + WS_W_13T) + (size_t)L * 5632 * D; ldwt = 1024; gain = INP(I_FFN) + L * D; } break;
        default: { const int L = job - 15; W = INP(I_FFW2) + (size_t)L * FF * D; ldw = 1024; K = FF; Nout = 1024; WT = (bf16_t*)(ws + WS_W_2T) + (size_t)L * D * FF; ldwt = FF; } break;
        }
        const int nblk = Nout / 32, kb = r / nblk, nb = r % nblk, n0 = nb * 32; int s0 = n0, nvalid = 32;
        if (job == 0) s0 = in0_src_col(n0);
        else if (job == 2) { if (n0 < 448) s0 = n0; else if (n0 == 448) { s0 = 448; nvalid = 8; } else if (n0 < 512) { s0 = 0; nvalid = 0; } else s0 = n0 - 56; }
        else if (job == 13 || job == 14) { const int pn = n0 >> 8, j = n0 & 255; s0 = j < 128 ? pn * 128 + j : 2816 + pn * 128 + (j - 128); }
        tr_item(W, ldw, kb * 64, s0, nvalid, WT, ldwt, n0, kout0, gain, scale, scr, F.lane);
    }
    const int gt = F.gw * 64 + F.lane, NGT = F.NGW * 64;
    { const float* wuq = INP(I_OWUQ); const float* wuk = INP(I_OWUK); const float* g = INP(I_OCQN); bf16_t* WT = (bf16_t*)(ws + WS_W_Q1T);
      for (int o = gt; o < 1024 * 256; o += NGT) { const int n = o & 1023, r = o >> 10, h = n >> 7, c = n & 127; float s = 0.f;
          for (int d = 0; d < 64; ++d) s += wuq[(size_t)r * 512 + h * 64 + d] * wuk[(size_t)(h * 64 + d) * 128 + c];
          WT[(size_t)n * 256 + r] = (bf16_t)(cvt_pk_bf16(s * 0.125f * g[r], 0.f) & 0xffffu); } }
    { const float* wuv = INP(I_OWUV); const float* wo = INP(I_OWOUT); bf16_t* WT = (bf16_t*)(ws + WS_W_OUT1T);
      for (int o = gt; o < 1024 * 1024; o += NGT) { const int n = o & 1023, k = o >> 10, h = k >> 7; float s = 0.f;
          for (int d = 0; d < 64; ++d) s += wuv[(size_t)k * 64 + d] * wo[(size_t)(h * 64 + d) * 1024 + n];
          WT[(size_t)n * 1536 + k] = (bf16_t)(cvt_pk_bf16(s, 0.f) & 0xffffu); } }
    { const float* wq = INP(I_XAWQ); const float* g = INP(I_XAN); bf16_t* WN = (bf16_t*)(ws + WS_W_XQT);
      for (int o = gt; o < 2 * D * D / 4; o += NGT) { const f32x4 v = *((const f32x4*)wq + o); const float gg = g[(o * 4) >> 10]; *((u32x2*)WN + o) = pack4(v * gg); } }
    { const float* wsrc = INP(I_ODWS); bf16_t* WC = (bf16_t*)(ws + WS_WC);
      for (int o = gt; o < 4 * 128 * 128; o += NGT) { const int s = o & 127, t = (o >> 7) & 127; WC[o] = (bf16_t)(cvt_pk_bf16(s <= t ? wsrc[o] : 0.f, 0.f) & 0xffffu); }
      const float* hl = INP(I_HLB); float* lb = (float*)(ws + WS_LB);
      for (int o = gt; o < 512; o += NGT) { const float x0 = hl[o], x1 = hl[512 + o], x2 = hl[1024 + o], mx = fmaxf(x0, fmaxf(x1, x2));
          const float e0 = __expf(x0 - mx), e1 = __expf(x1 - mx), e2 = __expf(x2 - mx); lb[o] = e0 / (e0 + e1 + e2); } }
    { const float* x = INP(I_X); bf16_t* XB = (bf16_t*)(ws + WS_XB); float* rsp = (float*)(ws + WS_RSP);
      for (int m = F.gw; m < M + MROWS; m += F.NGW) {
          const bool is_mem = m >= M; const int row = is_mem ? m - M : m;
          const float* src = is_mem ? INP(I_MEM) + (size_t)row * D : x + (size_t)row * D; bf16_t* dst = is_mem ? (bf16_t*)(ws + WS_MEMB) + (size_t)row * D : XB + (size_t)row * D;
          const f32x4* xr = (const f32x4*)src + F.lane; f32x4 v[4]; float s = 0.f;
#pragma unroll
          for (int j = 0; j < 4; ++j) { v[j] = xr[64 * j]; s += (v[j].x * v[j].x + v[j].y * v[j].y) + (v[j].z * v[j].z + v[j].w * v[j].w); }
          s = wave_sum(s);
          u32x2* o8 = (u32x2*)dst + F.lane;
#pragma unroll
          for (int j = 0; j < 4; ++j) { u32x2 w; w.x = cvt_pk_bf16(v[j].x, v[j].y); w.y = cvt_pk_bf16(v[j].z, v[j].w); o8[64 * j] = w; }
          if (F.lane == 0) { if (is_mem) ((float*)(ws + WS_MEMRS))[row] = fast_rsq(s * (1.0f / D) + 1e-6f); else *(f32x4*)(rsp + (size_t)row * 4) = (f32x4){s, 0.f, 0.f, 0.f}; }
      } }
}


struct EpiRes { static constexpr bool PERM = true; static constexpr bool RSPRE = false;
    bf16_t* xb; float* rsp_out;
    __device__ __forceinline__ void operator()(AccRef acc, const Unit& u, const EpiCtx& cx) const {
        LAS float* T = (LAS float*)cx.xl;
        const int col0 = u.pn * 256 + cx.wc * 32 + 8 * cx.fq;
#pragma unroll
        for (int ai = 0; ai < 2; ++ai) {
            u32x4 xo[4][2];
#pragma unroll
            for (int m = 0; m < 4; ++m)
#pragma unroll
                for (int bj = 0; bj < 2; ++bj) xo[m][bj] = *(const u32x4*)(xb + (size_t)(u.pm * 256 + ai * 128 + cx.wr * 64 + m * 16 + cx.fr) * D + col0 + bj * 128);
#pragma unroll
            for (int m = 0; m < 4; ++m) { const int rl = ai * 128 + cx.wr * 64 + m * 16 + cx.fr; const size_t off = (size_t)(u.pm * 256 + rl) * D + col0; float ss = 0.f;
#pragma unroll
                for (int bj = 0; bj < 2; ++bj) { const u32x4 xv = xo[m][bj];
                    const f32x4 v0 = (f32x4){bflo(xv.x), bfhi(xv.x), bflo(xv.y), bfhi(xv.y)} + acc[ai][bj][m][0], v1 = (f32x4){bflo(xv.z), bfhi(xv.z), bflo(xv.w), bfhi(xv.w)} + acc[ai][bj][m][1];
                    *(u32x4*)(xb + off + bj * 128) = pack8(v0, v1);
                    ss += ((v0[0] * v0[0] + v0[1] * v0[1]) + (v0[2] * v0[2] + v0[3] * v0[3])) + ((v1[0] * v1[0] + v1[1] * v1[1]) + (v1[2] * v1[2] + v1[3] * v1[3])); }
                ss = red_fq(ss); if (cx.fq == 0) T[rl * 4 + cx.wc] = ss; }
            asm volatile("" ::: "memory"); }
        LDS_BAR();
        const int tid = cx.wid * 64 + cx.lane;
        if (tid < 256) { const f32x4 t = *(const LAS f32x4*)(T + tid * 4); rsp_out[(size_t)(u.pm * 256 + tid) * 4 + u.pn] = (t[0] + t[1]) + (t[2] + t[3]); }
    }
};
struct EpiBf { static constexpr bool PERM = true; static constexpr bool RSPRE = false;
    bf16_t* O; int ldc; const float* rsv; int rs_mode; int split_pn; bf16_t* O2; int ldc2; int pn_stride;
    __device__ __forceinline__ void operator()(AccRef acc, const Unit& u, const EpiCtx& cx) const {
        bf16_t* base = O; int ld = ldc, pn = u.pn; if (pn >= split_pn) { base = O2; ld = ldc2; pn -= split_pn; }
        const size_t col0 = (size_t)pn * pn_stride + cx.wc * 32 + 8 * cx.fq;
        float rsa[2][4];
        if (rs_mode == 1) load_rs(rsv, u, cx, 1.0f / 1024.f, 1e-6f, rsa);
        else {
#pragma unroll
            for (int ai = 0; ai < 2; ++ai)
#pragma unroll
                for (int m = 0; m < 4; ++m) rsa[ai][m] = rs_mode == 2 ? rsv[u.pm * 256 + ai * 128 + cx.wr * 64 + m * 16 + cx.fr] : 1.f; }
#pragma unroll
        for (int ai = 0; ai < 2; ++ai)
#pragma unroll
            for (int m = 0; m < 4; ++m) { const int row = u.pm * 256 + ai * 128 + cx.wr * 64 + m * 16 + cx.fr; const float rs = rsa[ai][m];
                bf16_t* rowp = base + (size_t)row * ld + col0;
#pragma unroll
                for (int bj = 0; bj < 2; ++bj) *(u32x4*)(rowp + bj * 128) = pack8(acc[ai][bj][m][0] * rs, acc[ai][bj][m][1] * rs); }
    }
};
struct EpiS { static constexpr bool PERM = true; static constexpr bool RSPRE = true;
    __device__ __forceinline__ const float* rs_src() const { return rsp; }
    bf16_t* P; const float* rsp;
    __device__ __forceinline__ void operator()(AccRef acc, const Unit& u, const EpiCtx& cx) const {
        LAS float* MX = (LAS float*)cx.xl; LAS float* SM = MX + 1024;
        const float sc = 0.0625f * 1.4426950408889634f;
        { float rs[2][4]; load_rs_lds(cx, 1.0f / 1024.f, 1e-6f, rs);
#pragma unroll
          for (int ai = 0; ai < 2; ++ai)
#pragma unroll
              for (int m = 0; m < 4; ++m)
#pragma unroll
                  for (int bj = 0; bj < 2; ++bj)
#pragma unroll
                      for (int n = 0; n < 2; ++n) acc[ai][bj][m][n] = acc[ai][bj][m][n] * rs[ai][m]; }
#pragma unroll
        for (int ai = 0; ai < 2; ++ai)
#pragma unroll
            for (int m = 0; m < 4; ++m) { const int rl = ai * 128 + cx.wr * 64 + m * 16 + cx.fr; float mx = -3.0e38f;
#pragma unroll
                for (int bj = 0; bj < 2; ++bj)
#pragma unroll
                    for (int n = 0; n < 2; ++n) { const f32x4 v = acc[ai][bj][m][n]; mx = fmaxf(mx, fmaxf(fmaxf(v[0], v[1]), fmaxf(v[2], v[3]))); }
                mx = max_fq(mx); if (cx.fq == 0) MX[rl * 4 + cx.wc] = mx; }
        LDS_BAR();
#pragma unroll
        for (int ai = 0; ai < 2; ++ai)
#pragma unroll
            for (int m = 0; m < 4; ++m) { const int rl = ai * 128 + cx.wr * 64 + m * 16 + cx.fr; const f32x4 t = *(const LAS f32x4*)(MX + rl * 4);
                const float mx = fmaxf(fmaxf(t[0], t[1]), fmaxf(t[2], t[3])) * sc; float s = 0.f;
#pragma unroll
                for (int bj = 0; bj < 2; ++bj)
#pragma unroll
                    for (int n = 0; n < 2; ++n) { f32x4 v = acc[ai][bj][m][n];
#pragma unroll
                        for (int i = 0; i < 4; ++i) { v[i] = fast_exp2(v[i] * sc - mx); s += v[i]; }
                        acc[ai][bj][m][n] = v; }
                s = red_fq(s); if (cx.fq == 0) SM[rl * 4 + cx.wc] = s; }
        LDS_BAR();
        const int col0 = u.pn * 256 + cx.wc * 32 + 8 * cx.fq;
#pragma unroll
        for (int ai = 0; ai < 2; ++ai)
#pragma unroll
            for (int m = 0; m < 4; ++m) { const int rl = ai * 128 + cx.wr * 64 + m * 16 + cx.fr; const f32x4 t = *(const LAS f32x4*)(SM + rl * 4);
                const float inv = fast_rcp((t[0] + t[1]) + (t[2] + t[3])); bf16_t* rowp = P + (size_t)(u.pm * 256 + rl) * D + col0;
#pragma unroll
                for (int bj = 0; bj < 2; ++bj) *(u32x4*)(rowp + bj * 128) = pack8(acc[ai][bj][m][0] * inv, acc[ai][bj][m][1] * inv); }
    }
};
struct EpiFfn1 { static constexpr bool PERM = true; static constexpr bool RSPRE = true;
    bf16_t* ACT; const float* rsp;
    __device__ __forceinline__ const float* rs_src() const { return rsp; }
    __device__ __forceinline__ void operator()(AccRef acc, const Unit& u, const EpiCtx& cx) const {
        const int col0 = u.pn * 128 + cx.wc * 32 + 8 * cx.fq;
        float rsa[2][4]; load_rs_lds(cx, 1.0f / 1024.f, 1e-6f, rsa);
        LDS_BAR();
#pragma unroll
        for (int ai = 0; ai < 2; ++ai)
#pragma unroll
            for (int m = 0; m < 4; ++m) { const int row = u.pm * 256 + ai * 128 + cx.wr * 64 + m * 16 + cx.fr;
                const float rs = rsa[ai][m]; f32x4 o[2];
#pragma unroll
                for (int n = 0; n < 2; ++n)
#pragma unroll
                    for (int i = 0; i < 4; ++i) o[n][i] = silu_f(acc[ai][0][m][n][i] * rs) * (acc[ai][1][m][n][i] * rs);
                *(u32x4*)(ACT + (size_t)row * FF + col0) = pack8(o[0], o[1]); }
    }
};
template <int CTRL> __device__ __forceinline__ float dppf(float v) { return __builtin_bit_cast(float, __builtin_amdgcn_update_dpp(0, __builtin_bit_cast(int, v), CTRL, 0xf, 0xf, true)); }
__device__ __forceinline__ float row_scan16(float v) { v += dppf<0x111>(v); v += dppf<0x112>(v); v += dppf<0x114>(v); v += dppf<0x118>(v); return v; }
__device__ __forceinline__ float row_last16(float v) { return dppf<0x15F>(v); }
__device__ __forceinline__ float row_sum16(float v) { v += dppf<0x128>(v); v += dppf<0x124>(v); v += dppf<0x122>(v); v += dppf<0x121>(v); return v; }

struct EpiIn0 { static constexpr bool PERM = true; static constexpr bool RSPRE = true;
    unsigned char* ws;
    __device__ __forceinline__ const float* rs_src() const { return (const float*)(ws + WS_RSP); }
    __device__ __forceinline__ void operator()(AccRef acc, const Unit& u, const EpiCtx& cx) const {
        const float* rsp = (const float*)(ws + WS_RSP); const float* lb = (const float*)(ws + WS_LB); bf16_t* QE = (bf16_t*)(ws + WS_QE); bf16_t* KINV = (bf16_t*)(ws + WS_KINV); bf16_t* HZ = (bf16_t*)(ws + WS_HZ); float* EBG = (float*)(ws + WS_EBG);
        float rs[2][4]; load_rs_lds(cx, 1.0f / 1024.f, 1e-6f, rs); (void)rsp;
        LDS_BAR();
        const int pn = u.pn;
        if (pn < 4) {
            const int ch0 = pn * 128 + cx.wc * 32 + 8 * cx.fq;
#pragma unroll
            for (int ai = 0; ai < 2; ++ai) {
                const int row0 = u.pm * 256 + ai * 128 + cx.wr * 64;
#pragma unroll
                for (int n = 0; n < 2; ++n) {
                    const f32x4 lbv = *(const f32x4*)(lb + ch0 + 4 * n);
                    f32x4 oq[4], oi[4], eb;
#pragma unroll
                    for (int i = 0; i < 4; ++i) {
                        float l2[4], kk[4], tot[4];
#pragma unroll
                        for (int m = 0; m < 4; ++m) { const float x = acc[ai][1][m][n][i] * rs[ai][m]; const float f = lbv[i] + (1.0f - lbv[i]) * sigmoid_f(x);
                            kk[m] = 1.0f - f; l2[m] = row_scan16(__builtin_amdgcn_logf(f)); tot[m] = row_last16(l2[m]); }
                        const float btot = (tot[0] + tot[1]) + (tot[2] + tot[3]); float pre = 0.f;
#pragma unroll
                        for (int m = 0; m < 4; ++m) { const float b = l2[m] + pre; pre += tot[m];
                            const float q = silu_f(acc[ai][0][m][n][i] * rs[ai][m]);
                            oq[m][i] = q * fast_exp2(b); oi[m][i] = kk[m] * fast_exp2(fminf(-b, 100.f)); }
                        eb[i] = fast_exp2(btot);
                    }
#pragma unroll
                    for (int m = 0; m < 4; ++m) { const size_t o = (size_t)(row0 + m * 16 + cx.fr) * 512 + ch0 + 4 * n;
                        *(u32x2*)(QE + o) = pack4(oq[m]); *(u32x2*)(KINV + o) = pack4(oi[m]); }
                    if (cx.fr == 0) *(f32x4*)(EBG + (size_t)(row0 >> 6) * 512 + ch0 + 4 * n) = eb;
                    __builtin_amdgcn_sched_barrier(0);
                }
            }
        } else if (pn < 10) {
            bf16_t* T = (bf16_t*)(ws + (pn < 6 ? WS_HV : (pn < 8 ? WS_HG : WS_HB))); const bool act = (pn == 6 || pn == 7);
            const int col0 = (pn & 1) * 256 + cx.wc * 32 + 8 * cx.fq;
#pragma unroll
            for (int ai = 0; ai < 2; ++ai)
#pragma unroll
                for (int m = 0; m < 4; ++m) { const int row = u.pm * 256 + ai * 128 + cx.wr * 64 + m * 16 + cx.fr; const float r = rs[ai][m];
#pragma unroll
                    for (int bj = 0; bj < 2; ++bj) { f32x4 a = acc[ai][bj][m][0] * r, b = acc[ai][bj][m][1] * r;
                        if (act) {
#pragma unroll
                            for (int i = 0; i < 4; ++i) { a[i] = silu_f(a[i]); b[i] = silu_f(b[i]); } }
                        *(u32x4*)(T + (size_t)row * 512 + col0 + bj * 128) = pack8(a, b); } }
        } else {
            const int col0 = (pn - 10) * 128 + cx.wc * 32 + 8 * cx.fq;
#pragma unroll
            for (int ai = 0; ai < 2; ++ai)
#pragma unroll
                for (int m = 0; m < 4; ++m) { const int row = u.pm * 256 + ai * 128 + cx.wr * 64 + m * 16 + cx.fr; const float r2 = rs[ai][m] * rs[ai][m];
                    *(u32x4*)(HZ + (size_t)row * 512 + col0) = pack8(acc[ai][0][m][0] * acc[ai][1][m][0] * r2, acc[ai][0][m][1] * acc[ai][1][m][1] * r2); }
        }
    }
};
__device__ __forceinline__ unsigned off_b(unsigned row, unsigned ch) { return 256u * row + 16u * (ch ^ (((row & 3) << 2) | ((row >> 2) & 3))); }
__device__ __forceinline__ s16x4 ldtr(const LAS unsigned char* p) { return __builtin_amdgcn_ds_read_tr16_b64_v4i16((LAS s16x4*)p); }
__device__ __forceinline__ bf16x8 mk8(s16x4 a, s16x4 b) { return (bf16x8){a[0], a[1], a[2], a[3], b[0], b[1], b[2], b[3]}; }
__device__ __forceinline__ s16x4 tr_blk(const LAS unsigned char* img, int r0, int c, int lane) { const int q = (lane & 15) >> 2, p = lane & 3; return ldtr(img + off_b(r0 + q, 2 * c + (p >> 1)) + 8 * (p & 1)); }
__device__ __forceinline__ void unpack8(u32x4 w, float (&f)[8]) { f[0] = bflo(w.x); f[1] = bfhi(w.x); f[2] = bflo(w.y); f[3] = bfhi(w.y); f[4] = bflo(w.z); f[5] = bfhi(w.z); f[6] = bflo(w.w); f[7] = bfhi(w.w); }
__device__ __forceinline__ u32x4 pack8f(const float (&f)[8]) { u32x4 w; w.x = cvt_pk_bf16(f[0], f[1]); w.y = cvt_pk_bf16(f[2], f[3]); w.z = cvt_pk_bf16(f[4], f[5]); w.w = cvt_pk_bf16(f[6], f[7]); return w; }
#define MFMA16(A, B, C) __builtin_amdgcn_mfma_f32_16x16x32_bf16((A), (B), (C), 0, 0, 0)

constexpr int HG_BUF = 66048, HG_ATT = 2 * HG_BUF, HG_ATT_ROW = 144;
constexpr int HG_NSEG = 8, HG_SEGC = (SEQ / 64) / HG_NSEG;
__device__ __forceinline__ void hgrn_unit(const Frame& F, unsigned char* ws, int unit) {
    const int b = unit >> 5, h = (unit >> 3) & 3, seg = unit & 7, c0 = seg * HG_SEGC;
    const int tid = F.tid, lane0 = F.lane, w = F.wave;
    const unsigned char* gsrc = ws + WS_BIG1; const float* EBG = (const float*)(ws + WS_EBG); bf16_t* HO = (bf16_t*)(ws + WS_HO);
    LAS unsigned char* L = F.lds; LAS unsigned char* ATT = L + HG_ATT;
    u32x4 st[8]; f32x4 steb = (f32x4){0.f, 0.f, 0.f, 0.f};
    const int srow = (tid & 511) >> 4, sch = tid & 15;
#define HG_LOAD(ci) do { const size_t tok0_ = (size_t)b * SEQ + (size_t)(ci) * 64; \
        _Pragma("unroll") for (int j = 0; j < 8; ++j) if ((j >> 1) != 2) st[j] = *(const u32x4*)(gsrc + (size_t)(j >> 1) * T64 + ((tok0_ + srow + 32 * (j & 1)) * 512 + h * 128 + sch * 8) * 2); \
        if (tid < 32) steb = *(const f32x4*)(EBG + (tok0_ >> 6) * 512 + h * 128 + 4 * tid); } while (0)
#define HG_STORE(bufi) do { LAS unsigned char* B_ = L + (bufi) * HG_BUF; \
        _Pragma("unroll") for (int j = 0; j < 8; ++j) if ((j >> 1) != 2) *(LAS u32x4*)(B_ + (j >> 1) * 16384 + off_b(srow + 32 * (j & 1), sch)) = st[j]; \
        if (tid < 32) *(LAS f32x4*)(B_ + 65536 + 16 * tid) = steb; } while (0)
    f32x4 S[8];
#pragma unroll
    for (int kt = 0; kt < 8; ++kt) S[kt] = (f32x4){0.f, 0.f, 0.f, 0.f};
    {
      const float* SLOC = (const float*)(ws + WS_SLOC); const float* DSEG = (const float*)(ws + WS_DSEG); const int g_ = lane0 >> 4, c_ = lane0 & 15;
      f32x4 cum[8];
#pragma unroll
      for (int kt = 0; kt < 8; ++kt) cum[kt] = (f32x4){1.f, 1.f, 1.f, 1.f};
      for (int j = seg - 1; j >= 0; --j) { const int uj = (unit & ~7) | j; const float* sl = SLOC + (size_t)uj * 16384 + 16 * w + c_; const float* dj = DSEG + (size_t)uj * 128;
#pragma unroll
          for (int kt = 0; kt < 8; ++kt) { const f32x4 d4 = *(const f32x4*)(dj + 16 * kt + 4 * g_);
#pragma unroll
              for (int i = 0; i < 4; ++i) S[kt][i] += cum[kt][i] * sl[(16 * kt + 4 * g_ + i) * 128];
              cum[kt] = cum[kt] * d4; } } }
    HG_LOAD(c0); HG_STORE(0); LDS_BAR();
    for (int cr = 0; cr < HG_SEGC; ++cr) { const int ci = c0 + cr;
        const LAS unsigned char* B = L + (cr & 1) * HG_BUF; const LAS unsigned char* bQE = B; const LAS unsigned char* bKI = B + 16384; const LAS unsigned char* bKD = B + 32768; const LAS unsigned char* bV = B + 49152;
        const size_t tok0 = (size_t)b * SEQ + (size_t)ci * 64;
        const int lane = opq(lane0), g = lane >> 4, c = lane & 15;
        if (cr + 1 < HG_SEGC) HG_LOAD(ci + 1);
#pragma unroll
        for (int e = 0; e < 2; ++e) { const int id = 2 * w + e, mt = id >> 2, ns = id & 3; f32x4 acc = (f32x4){0.f, 0.f, 0.f, 0.f};
            if (mt >= ns) {
#pragma unroll
                for (int ks = 0; ks < 4; ++ks) { const bf16x8 Bq = *(const LAS bf16x8*)(bQE + off_b(16 * mt + c, 4 * ks + g)); const bf16x8 Ak = *(const LAS bf16x8*)(bKI + off_b(16 * ns + c, 4 * ks + g)); acc = MFMA16(Ak, Bq, acc); }
            }
            f32x4 v;
#pragma unroll
            for (int i = 0; i < 4; ++i) { const bool keep = (mt > ns) || (mt == ns && 4 * g + i <= c); v[i] = keep ? acc[i] : 0.f; }
            *(LAS u32x2*)(ATT + (16 * mt + c) * HG_ATT_ROW + (16 * ns + 4 * g) * 2) = pack4(v); }
        LDS_BAR();
        bf16x8 Sb[4];
#pragma unroll
        for (int ks = 0; ks < 4; ++ks) { u32x4 p; p.x = cvt_pk_bf16(S[2 * ks][0], S[2 * ks][1]); p.y = cvt_pk_bf16(S[2 * ks][2], S[2 * ks][3]); p.z = cvt_pk_bf16(S[2 * ks + 1][0], S[2 * ks + 1][1]); p.w = cvt_pk_bf16(S[2 * ks + 1][2], S[2 * ks + 1][3]); Sb[ks] = __builtin_bit_cast(bf16x8, p); }
        bf16x8 Vf[2];
#pragma unroll
        for (int k2 = 0; k2 < 2; ++k2) {
#if HG_DBG & 8
            bf16x8 t;
#pragma unroll
            for (int j = 0; j < 8; ++j) { const int srow_ = 32 * k2 + 8 * g + j, vcol = 16 * w + c; t[j] = *(const LAS short*)(bV + off_b(srow_, vcol >> 3) + (vcol & 7) * 2); }
            Vf[k2] = t;
#else
            Vf[k2] = mk8(tr_blk(bV, 32 * k2 + 8 * g, w, lane), tr_blk(bV, 32 * k2 + 8 * g + 4, w, lane));
#endif
        }
        f32x4 ao[4];
#pragma unroll
        for (int mt = 0; mt < 4; ++mt) { ao[mt] = (f32x4){0.f, 0.f, 0.f, 0.f};
#pragma unroll
            for (int ks = 0; ks < 4; ++ks) { const s16x4 a0 = *(const LAS s16x4*)(bQE + off_b(16 * mt + c, 4 * ks + (g >> 1)) + 8 * (g & 1)); const s16x4 a1 = *(const LAS s16x4*)(bQE + off_b(16 * mt + c, 4 * ks + 2 + (g >> 1)) + 8 * (g & 1));
                if (!(HG_DBG & 1)) ao[mt] = MFMA16(mk8(a0, a1), Sb[ks], ao[mt]); }
#pragma unroll
            for (int k2 = 0; k2 < 2; ++k2) { const bf16x8 A = *(const LAS bf16x8*)(ATT + (16 * mt + c) * HG_ATT_ROW + (32 * k2 + 8 * g) * 2); if (!(HG_DBG & 2)) ao[mt] = MFMA16(A, Vf[k2], ao[mt]); } }
#pragma unroll
        for (int mt = 0; mt < 4; ++mt)
#pragma unroll
            for (int i = 0; i < 4; ++i) HO[(tok0 + 16 * mt + 4 * g + i) * 512 + h * 128 + 16 * w + c] = (bf16_t)(cvt_pk_bf16(ao[mt][i], 0.f) & 0xffffu);
#pragma unroll
        for (int kt = 0; kt < 8; ++kt) { const f32x4 e4 = *(const LAS f32x4*)(B + 65536 + (16 * kt + 4 * g) * 4); f32x4 X = (f32x4){0.f, 0.f, 0.f, 0.f};
#pragma unroll
            for (int k2 = 0; k2 < 2; ++k2) { const bf16x8 A = mk8(tr_blk(bKI, 32 * k2 + 8 * g, kt, lane), tr_blk(bKI, 32 * k2 + 8 * g + 4, kt, lane)); X = MFMA16(A, Vf[k2], X); }
            S[kt] = S[kt] * e4 + X * e4; }
        if (cr + 1 < HG_SEGC) HG_STORE((cr + 1) & 1);
        LDS_BAR();
    }
#undef HG_LOAD
#undef HG_STORE
    WG_BAR();
    { const bf16_t* HG = (const bf16_t*)(ws + WS_HG); bf16_t* A0 = (bf16_t*)(ws + WS_A0); const int tl = lane0 >> 4, j = lane0 & 15; float gn[8];
#pragma unroll
      for (int i = 0; i < 8; ++i) gn[i] = INP(I_EAON)[h * 128 + 8 * j + i];
      const size_t tokf = (size_t)b * SEQ + (size_t)c0 * 64 + w * 128 + tl;
      u32x4 no_ = *(const u32x4*)(HO + tokf * 512 + h * 128 + 8 * j), ng_ = *(const u32x4*)(HG + tokf * 512 + h * 128 + 8 * j);
      for (int it = 0; it < 32; ++it) { const size_t tok = tokf + it * 4; const u32x4 co_ = no_, cg_ = ng_;
          if (it + 1 < 32) { const size_t offn = (tok + 4) * 512 + h * 128 + 8 * j; no_ = *(const u32x4*)(HO + offn); ng_ = *(const u32x4*)(HG + offn); }
          float o[8], gt[8], r[8]; unpack8(co_, o); unpack8(cg_, gt);
          float ss = 0.f;
#pragma unroll
          for (int i = 0; i < 8; ++i) ss += o[i] * o[i];
          ss = row_sum16(ss);
          const float rr = fast_rsq(ss * (1.0f / 128.f) + 1e-6f);
#pragma unroll
          for (int i = 0; i < 8; ++i) r[i] = o[i] * rr * gn[i] * gt[i];
          *(u32x4*)(A0 + tok * 1024 + h * 128 + 8 * j) = pack8f(r); } }
}
__device__ __forceinline__ void hgrn_passA(const Frame& F, unsigned char* ws, int unit) {
    const int b = unit >> 5, h = (unit >> 3) & 3, seg = unit & 7, c0 = seg * HG_SEGC;
    const int tid = F.tid, lane0 = F.lane, w = F.wave;
    const unsigned char* gsrc = ws + WS_BIG1; const float* EBG = (const float*)(ws + WS_EBG);
    LAS unsigned char* L = F.lds;
    constexpr int PA_BUF = 33280;
    u32x4 st[4]; f32x4 steb = (f32x4){0.f, 0.f, 0.f, 0.f};
    const int srow = (tid & 511) >> 4, sch = tid & 15;
#define PA_LOAD(ci) do { const size_t tok0_ = (size_t)b * SEQ + (size_t)(ci) * 64; \
        _Pragma("unroll") for (int j = 0; j < 4; ++j) st[j] = *(const u32x4*)(gsrc + (size_t)((j >> 1) ? 3 : 1) * T64 + ((tok0_ + srow + 32 * (j & 1)) * 512 + h * 128 + sch * 8) * 2); \
        if (tid < 32) steb = *(const f32x4*)(EBG + (tok0_ >> 6) * 512 + h * 128 + 4 * tid); } while (0)
#define PA_STORE(bufi) do { LAS unsigned char* B_ = L + (bufi) * PA_BUF; \
        _Pragma("unroll") for (int j = 0; j < 4; ++j) *(LAS u32x4*)(B_ + (j >> 1) * 16384 + off_b(srow + 32 * (j & 1), sch)) = st[j]; \
        if (tid < 32) *(LAS f32x4*)(B_ + 32768 + 16 * tid) = steb; } while (0)
    f32x4 S[8], dc[8];
#pragma unroll
    for (int kt = 0; kt < 8; ++kt) { S[kt] = (f32x4){0.f, 0.f, 0.f, 0.f}; dc[kt] = (f32x4){1.f, 1.f, 1.f, 1.f}; }
    PA_LOAD(c0); PA_STORE(0); LDS_BAR();
    for (int cr = 0; cr < HG_SEGC; ++cr) {
        const LAS unsigned char* B = L + (cr & 1) * PA_BUF; const LAS unsigned char* bKD = B; const LAS unsigned char* bV = B + 16384;
        const int lane = opq(lane0), g = lane >> 4;
        if (cr + 1 < HG_SEGC) PA_LOAD(c0 + cr + 1);
        bf16x8 Vf[2];
#pragma unroll
        for (int k2 = 0; k2 < 2; ++k2) Vf[k2] = mk8(tr_blk(bV, 32 * k2 + 8 * g, w, lane), tr_blk(bV, 32 * k2 + 8 * g + 4, w, lane));
#pragma unroll
        for (int kt = 0; kt < 8; ++kt) { const f32x4 e4 = *(const LAS f32x4*)(B + 32768 + (16 * kt + 4 * g) * 4); dc[kt] = dc[kt] * e4; f32x4 X = (f32x4){0.f, 0.f, 0.f, 0.f};
#pragma unroll
            for (int k2 = 0; k2 < 2; ++k2) { const bf16x8 A = mk8(tr_blk(bKD, 32 * k2 + 8 * g, kt, lane), tr_blk(bKD, 32 * k2 + 8 * g + 4, kt, lane)); X = MFMA16(A, Vf[k2], X); }
            S[kt] = S[kt] * e4 + X * e4; }
        if (cr + 1 < HG_SEGC) PA_STORE((cr + 1) & 1);
        LDS_BAR();
    }
    { float* sl = (float*)(ws + WS_SLOC) + (size_t)unit * 16384 + 16 * w + (lane0 & 15); float* dj = (float*)(ws + WS_DSEG) + (size_t)unit * 128; const int g = lane0 >> 4;
#pragma unroll
      for (int kt = 0; kt < 8; ++kt) {
#pragma unroll
          for (int i = 0; i < 4; ++i) sl[(16 * kt + 4 * g + i) * 128] = S[kt][i];
          if (w == 0 && (lane0 & 15) == 0) *(f32x4*)(dj + 16 * kt + 4 * g) = dc[kt]; } }
#undef PA_LOAD
#undef PA_STORE
}
__device__ __forceinline__ void conv_part(const Frame& F, unsigned char* ws, int wg, int nwg) {
    const bf16_t* HZ = (const bf16_t*)(ws + WS_HZ); const bf16_t* HB = (const bf16_t*)(ws + WS_HB); bf16_t* A0 = (bf16_t*)(ws + WS_A0);
    const float* wc = INP(I_EBCONV); const int T = wg * NTHR + F.tid, NT = nwg * NTHR, cg = T & 63;
    float w0[8], w1[8], w2[8];
#pragma unroll
    for (int j = 0; j < 8; ++j) { w0[j] = wc[cg * 8 + j]; w1[j] = wc[512 + cg * 8 + j]; w2[j] = wc[1024 + cg * 8 + j]; }
    for (int u = T; u < (M / 16) * 64; u += NT) { const size_t tok0 = (size_t)(u >> 6) * 16; const bool first = (tok0 & (SEQ - 1)) == 0;
        float z2[8], z1[8];
        if (first) {
#pragma unroll
            for (int j = 0; j < 8; ++j) { z2[j] = 0.f; z1[j] = 0.f; } }
        else { unpack8(*(const u32x4*)(HZ + (tok0 - 2) * 512 + cg * 8), z2); unpack8(*(const u32x4*)(HZ + (tok0 - 1) * 512 + cg * 8), z1); }
        for (int i = 0; i < 16; ++i) { float z0[8], bb[8], o[8]; unpack8(*(const u32x4*)(HZ + (tok0 + i) * 512 + cg * 8), z0); unpack8(*(const u32x4*)(HB + (tok0 + i) * 512 + cg * 8), bb);
#pragma unroll
            for (int j = 0; j < 8; ++j) { o[j] = bb[j] * (w0[j] * z2[j] + w1[j] * z1[j] + w2[j] * z0[j]); z2[j] = z1[j]; z1[j] = z0[j]; }
            *(u32x4*)(A0 + (tok0 + i) * 1024 + 512 + cg * 8) = pack8f(o); }
    }
}
__device__ __forceinline__ void hgrn_finalize(const Frame& F, unsigned char* ws) {
    const bf16_t* HO = (const bf16_t*)(ws + DBG_FIN_SRC); const bf16_t* HG = (const bf16_t*)(ws + WS_HG); bf16_t* A0 = (bf16_t*)(ws + WS_A0);
    const int hh = F.lane >> 4, j = F.lane & 15; float gn[8];
#pragma unroll
    for (int i = 0; i < 8; ++i) gn[i] = INP(I_EAON)[hh * 128 + 8 * j + i];
    for (int tok = F.gw; tok < M; tok += F.NGW) { const size_t off = (size_t)tok * 512 + hh * 128 + 8 * j; float o[8], gt[8], r[8]; unpack8(*(const u32x4*)(HO + off), o); unpack8(*(const u32x4*)(HG + off), gt);
        float ss = 0.f;
#pragma unroll
        for (int i = 0; i < 8; ++i) ss += o[i] * o[i];
        ss = row_sum16(ss);
        const float rr = fast_rsq(ss * (1.0f / 128.f) + 1e-6f);
#pragma unroll
        for (int i = 0; i < 8; ++i) r[i] = o[i] * rr * gn[i] * gt[i];
        *(u32x4*)(A0 + (size_t)tok * 1024 + hh * 128 + 8 * j) = pack8f(r); }
}
__device__ __forceinline__ void gmlp_unit(const Frame& F, unsigned char* ws, int unit) {
    const int grp = unit & 3, cidx = unit >> 2; const size_t tok0 = (size_t)cidx * 128;
    const bf16_t* DV = (const bf16_t*)(ws + WS_DV); const bf16_t* U = (const bf16_t*)(ws + WS_U); const bf16_t* WC = (const bf16_t*)(ws + WS_WC);
    bf16_t* A1 = (bf16_t*)(ws + WS_A1); const float* bs = INP(I_ODBS);
    const int tid = opq(F.tid), lane = tid & 63, w = F.wave, g4 = lane >> 4, c = lane & 15; LAS unsigned char* VN = F.lds;
#pragma unroll
    for (int j = 0; j < 4; ++j) { const int pc = tid + 512 * j, s = pc >> 4, ch = pc & 15; *(LAS u32x4*)(VN + off_b(s, ch)) = *(const u32x4*)(DV + (tok0 + s) * 512 + grp * 128 + ch * 8); }
    bf16x8 Bf[4]; const int nks = (w >> 1) + 1;
#pragma unroll
    for (int ks = 0; ks < 4; ++ks) Bf[ks] = *(const bf16x8*)(WC + ((size_t)grp * 128 + 16 * w + c) * 128 + 32 * ks + 8 * g4);
    LDS_BAR();
    const size_t tok = tok0 + 16 * w + c; const float bias = bs[grp * 128 + 16 * w + c];
    u32x2 uua[8];
#pragma unroll
    for (int mt = 0; mt < 8; ++mt) uua[mt] = *(const u32x2*)(U + tok * 512 + grp * 128 + 16 * mt + 4 * g4);
#pragma unroll
    for (int mt = 0; mt < 8; ++mt) { f32x4 acc = (f32x4){0.f, 0.f, 0.f, 0.f};
#pragma unroll
        for (int ks = 0; ks < 4; ++ks) if (ks < nks) { const bf16x8 A = mk8(tr_blk(VN, 32 * ks + 8 * g4, mt, lane), tr_blk(VN, 32 * ks + 8 * g4 + 4, mt, lane)); acc = MFMA16(A, Bf[ks], acc); }
        const int ch = grp * 128 + 16 * mt + 4 * g4; const u32x2 uu = uua[mt];
        f32x4 o; o[0] = bflo(uu.x) * (acc[0] + bias); o[1] = bfhi(uu.x) * (acc[1] + bias); o[2] = bflo(uu.y) * (acc[2] + bias); o[3] = bfhi(uu.y) * (acc[3] + bias);
        *(u32x2*)(A1 + tok * 1536 + 1024 + ch) = pack4(o);
        __builtin_amdgcn_sched_barrier(0); }
    LDS_BAR();
}

constexpr int DS_HIST = 0, DS_OIDX = 131072, DS_WQ = 147456, DS_ST = 148480, DS_PEND = 149504, DS_QBAR = 149632;
constexpr unsigned DS_SELALL = 99u, DS_CAP = 512u;
__device__ __forceinline__ unsigned lds_add(LAS unsigned* p, unsigned v) { return __hip_atomic_fetch_add(p, v, __ATOMIC_RELAXED, __HIP_MEMORY_SCOPE_WORKGROUP); }
__device__ __forceinline__ unsigned lds_or(LAS unsigned* p, unsigned v) { return __hip_atomic_fetch_or(p, v, __ATOMIC_RELAXED, __HIP_MEMORY_SCOPE_WORKGROUP); }
__device__ __forceinline__ unsigned f2key(float s) { unsigned u = __float_as_uint(s); if (u == 0x80000000u) u = 0u; return (u & 0x80000000u) ? ~u : (u | 0x80000000u); }

__device__ __forceinline__ int lin_bin(float s) { return (int)__builtin_amdgcn_fmed3f(__builtin_fmaf(s, 128.f, 1024.f), 0.f, 2047.f); }
template <bool V> struct BoolC { static constexpr bool v = V; };
template <int MODE, bool LVL0>
__device__ __forceinline__ void dsa_pass(const bf16x8 (&afr)[4][4], const LAS unsigned char* alin_p, const bf16_t* KI, int t0, LAS unsigned char* L, int w, int lane, int lvl, unsigned short* scr) {
    const int h2 = lane >> 5, c = lane & 31, nkt = (t0 >> 5) + 1;
    LAS unsigned* ST = (LAS unsigned*)(L + DS_ST); const LAS float* WQ = (const LAS float*)(L + DS_WQ);
    LAS unsigned short* OIDX = (LAS unsigned short*)(L + DS_OIDX); LAS unsigned long long* CAND = (LAS unsigned long long*)(L + DS_HIST);
    const int mt0 = (w >> 2) * 4;
    int qa[4][2]; unsigned actm = 0u;
#pragma unroll
    for (int mt = 0; mt < 4; ++mt)
#pragma unroll
        for (int i = 0; i < 2; ++i) { const int q = 4 * (mt0 + mt) + 2 * h2 + i; const unsigned plen = ST[q * 8 + 1], lb1 = ST[q * 8 + 6];
            if (MODE == 0 && LVL0) { qa[mt][i] = 0; actm |= (ST[q * 8 + 5] == 0u) ? (1u << (2 * mt + i)) : 0u; }
            else if (MODE == 0) qa[mt][i] = (ST[q * 8 + 5] == 0u) ? (int)lb1 : -1000;
            else qa[mt][i] = (int)(lb1 | ((plen == DS_SELALL ? 0u : 32u - plen) << 16)); }
    const unsigned sh1 = lvl >= 2 ? 32u - 11u * (unsigned)(lvl - 1) : 0u, sh2 = lvl == 1 ? 21u : (lvl == 2 ? 10u : 0u), bmask = lvl == 3 ? 1023u : 2047u;
    f32x4 wreg[4][2][2];
#pragma unroll
    for (int mt = 0; mt < 4; ++mt)
#pragma unroll
        for (int i = 0; i < 2; ++i) { const int q = 4 * (mt0 + mt) + 2 * h2 + i; if (MODE != 1) { wreg[mt][i][0] = *(const LAS f32x4*)(WQ + q * 8); wreg[mt][i][1] = *(const LAS f32x4*)(WQ + q * 8 + 4); } }
    LAS unsigned char* hbase = L + DS_HIST + (2 * h2 + 4 * mt0) * 4096;
    constexpr bool PF = false && (MODE == 0 && LVL0);
    bf16x8 bnx[4];
    if (PF && (w & 3) < nkt) {
#pragma unroll
        for (int ks = 0; ks < 4; ++ks) bnx[ks] = *(const bf16x8*)(KI + (size_t)((w & 3) * 32 + c) * 64 + 16 * ks + 8 * h2); }
    for (int kt = (w & 3); kt < nkt; kt += 4) {
        const int key0 = kt * 32; const bool lastt = (kt == nkt - 1);
        const int c2 = (lastt ? c : 0) - 2 * h2;
        bf16x8 bfr[4];
        if (PF) {
#pragma unroll
            for (int ks = 0; ks < 4; ++ks) bfr[ks] = bnx[ks];
            if (kt + 4 < nkt) {
#pragma unroll
                for (int ks = 0; ks < 4; ++ks) bnx[ks] = *(const bf16x8*)(KI + (size_t)(key0 + 128 + c) * 64 + 16 * ks + 8 * h2); }
        } else {
#pragma unroll
            for (int ks = 0; ks < 4; ++ks) bfr[ks] = *(const bf16x8*)(KI + (size_t)(key0 + c) * 64 + 16 * ks + 8 * h2); }
        const unsigned voffb = (unsigned)(((2 * h2 + 4 * mt0) * 8192 + key0 + c) * 2);
        auto tile_body = [&](auto mc_) { constexpr bool MASKED = decltype(mc_)::v;
        f32x16 accl;
#pragma unroll
        for (int i = 0; i < 16; ++i) accl[i] = 0.f;
#pragma unroll
        for (int ks = 0; ks < 4; ++ks) accl = __builtin_amdgcn_mfma_f32_32x32x16_bf16(*(const LAS bf16x8*)(alin_p + 32 * ks), bfr[ks], accl, 0, 0, 0);
#pragma unroll
        for (int mt = 0; mt < 4; ++mt) {
            f32x16 acc;
#pragma unroll
            for (int i = 0; i < 16; ++i) acc[i] = 0.f;
#pragma unroll
            for (int ks = 0; ks < 4; ++ks) acc = __builtin_amdgcn_mfma_f32_32x32x16_bf16(afr[mt][ks], bfr[ks], acc, 0, 0, 0);
#pragma unroll
            for (int i = 0; i < 2; ++i) {
                const int q = 4 * (mt0 + mt) + 2 * h2 + i, qu = 4 * (mt0 + mt) + i;
                const f32x4 wa = (MODE != 1) ? wreg[mt][i][0] : *(const LAS f32x4*)(WQ + q * 8), wb = (MODE != 1) ? wreg[mt][i][1] : *(const LAS f32x4*)(WQ + q * 8 + 4);
                float s = wa[0] * __builtin_fabsf(acc[8 * i + 0]);
                s = __builtin_fmaf(wa[1], __builtin_fabsf(acc[8 * i + 1]), s); s = __builtin_fmaf(wa[2], __builtin_fabsf(acc[8 * i + 2]), s); s = __builtin_fmaf(wa[3], __builtin_fabsf(acc[8 * i + 3]), s);
                s = __builtin_fmaf(wb[0], __builtin_fabsf(acc[8 * i + 4]), s); s = __builtin_fmaf(wb[1], __builtin_fabsf(acc[8 * i + 5]), s); s = __builtin_fmaf(wb[2], __builtin_fabsf(acc[8 * i + 6]), s); s = __builtin_fmaf(wb[3], __builtin_fabsf(acc[8 * i + 7]), s);
                s = 0.5f * (s + accl[2 * mt + i]);
                const _Float16 hs = (_Float16)s; s = (float)hs;
                const unsigned lb = (unsigned)lin_bin(s);
                if (MODE == 0 && LVL0) *(unsigned short*)((unsigned char*)(scr + (4 * mt + i) * 8192) + voffb) = __builtin_bit_cast(unsigned short, hs);
                if (MODE == 0 && LVL0) {
                    unsigned inc = 1u << ((lb & 1u) << 4); if (MASKED) inc = (c2 <= qu) ? inc : 0u;
                    lds_add((LAS unsigned*)(hbase + (4 * mt + i) * 4096 + (lb >> 1) * 4), inc);
                } else if (MODE == 0) {
                    const unsigned key = f2key(s);
                    if (c2 <= qu && (int)(lb + 1u) == qa[mt][i] && (lvl == 1 || (key >> sh1) == ST[q * 8 + 0])) { const unsigned bin = (key >> sh2) & bmask; lds_add((LAS unsigned*)(hbase + (4 * mt + i) * 4096 + (bin >> 1) * 4), 1u << (16u * (bin & 1u))); }
                } else {
                    const unsigned st = (unsigned)qa[mt][i], thr1 = st & 0xffffu, lb1 = lb + 1u;
                    if (c2 <= qu && lb1 >= thr1) {
                        const unsigned key = f2key(s); bool sel = lb1 > thr1;
                        if (!sel) { const unsigned pfx = (unsigned)((unsigned long long)key >> (st >> 16)), px = ST[q * 8 + 0]; if (pfx < px) continue; sel = pfx > px; }
                        if (sel) { const unsigned slot = lds_add(&ST[q * 8 + 3], 1u); if (slot < 256u) OIDX[q * 256 + slot] = (unsigned short)(key0 + c); }
                        else { const unsigned slot = lds_add(&ST[q * 8 + 4], 1u); if (slot < DS_CAP) CAND[q * 512 + slot] = ((unsigned long long)key << 13) | (unsigned long long)(8191 - (key0 + c)); } }
                }
            }
        }
        };
        if (MODE == 0 && LVL0 && !lastt) tile_body(BoolC<false>{}); else tile_body(BoolC<true>{});
    }
}

__device__ __forceinline__ void dsa_resolve(LAS unsigned char* L, const LAS unsigned long long* CANDq, int q, int lane) {
    LAS unsigned* ST = (LAS unsigned*)(L + DS_ST); LAS unsigned short* OIDX = (LAS unsigned short*)(L + DS_OIDX);
    const unsigned plen = ST[q * 8 + 1];
    if (plen == DS_SELALL) return;
    const unsigned need = ST[q * 8 + 2], ncand = ST[q * 8 + 4], n = ncand < DS_CAP ? ncand : DS_CAP, prefix = ST[q * 8 + 0]; const int nj = (int)((n + 63u) >> 6);
    if (n <= 64u) {
        const unsigned long long v = (unsigned)lane < n ? CANDq[lane] : 0ull; const unsigned vlo = (unsigned)v, vhi = (unsigned)(v >> 32); unsigned rank = 0;
        for (unsigned j = 0; j < n; ++j) { const unsigned olo = __builtin_amdgcn_readlane(vlo, j), ohi = __builtin_amdgcn_readlane(vhi, j); const unsigned long long o = ((unsigned long long)ohi << 32) | olo; rank += (o > v) ? 1u : 0u; }
        if ((unsigned)lane < n && rank < need) { const unsigned slot = lds_add(&ST[q * 8 + 3], 1u); if (slot < 256u) OIDX[q * 256 + slot] = (unsigned short)(8191u - (unsigned)(v & 8191ull)); }
    } else {
        unsigned long long v[8];
#pragma unroll
        for (int j = 0; j < 8; ++j) { const unsigned idx = lane + 64 * j; v[j] = (j < nj && idx < n) ? CANDq[idx] : 0ull; }
        unsigned long long T = (plen >= 32u) ? ((unsigned long long)prefix << 13) : (plen == 0u ? 0ull : ((unsigned long long)prefix << (45u - plen)));
        for (int bit = 44 - (int)plen; bit >= 0; --bit) { const unsigned long long trial = T | (1ull << bit); unsigned cnt = 0;
#pragma unroll
            for (int j = 0; j < 8; ++j) if (j < nj) cnt += (unsigned)__popcll(__ballot(v[j] >= trial));
            if (cnt >= need) T = trial; }
#pragma unroll
        for (int j = 0; j < 8; ++j) if (j < nj && v[j] >= T && v[j] != 0ull) { const unsigned slot = lds_add(&ST[q * 8 + 3], 1u); if (slot < 256u) OIDX[q * 256 + slot] = (unsigned short)(8191u - (unsigned)(v[j] & 8191ull)); }
    }
}
__device__ __forceinline__ unsigned thresh_half(int T) { const _Float16 h = (_Float16)((float)(T - 1024) * (1.0f / 128.f)); const unsigned b = (unsigned)__builtin_bit_cast(unsigned short, h);
    return T <= 0 ? 0xFC00u : (T >= 2048 ? 0x7C00u : (T == 1024 ? 0x8004u : b)); }
typedef _Float16 half2_t __attribute__((ext_vector_type(2)));
template <int CTRL> __device__ __forceinline__ unsigned dppu(unsigned v) { return (unsigned)__builtin_amdgcn_update_dpp(0, (int)v, CTRL, 0xf, 0xf, true); }
__device__ __forceinline__ unsigned wave_incl_scan(unsigned v) {
    v += dppu<0x111>(v); v += dppu<0x112>(v); v += dppu<0x114>(v); v += dppu<0x118>(v);
    v += (unsigned)__builtin_amdgcn_update_dpp(0, (int)v, 0x142, 0xA, 0xF, false); v += (unsigned)__builtin_amdgcn_update_dpp(0, (int)v, 0x143, 0xC, 0xF, false); return v; }
__device__ __forceinline__ void dsa_emit_stored(const unsigned short* scr, int t0, LAS unsigned char* L, int w, int lane) {
    LAS unsigned* ST = (LAS unsigned*)(L + DS_ST); LAS unsigned short* OIDX = (LAS unsigned short*)(L + DS_OIDX);
    LAS unsigned* LIST = (LAS unsigned*)(L + DS_HIST + w * 16384); LAS unsigned long long* CANDW = (LAS unsigned long long*)(L + DS_HIST + w * 16384 + 4096);
    constexpr int RD = 8;
    u32x4 buf[RD];
    if (ST[(4 * w) * 8 + 1] != DS_SELALL) {
        const unsigned short* row0 = scr + (4 * w) * 8192 + lane * 8; const int nr0 = ((t0 + 4 * w) >> 9) + 1;
#pragma unroll
        for (int u = 0; u < RD; ++u) if (u < nr0) buf[u] = *(const u32x4*)(row0 + u * 512); }
    for (int qi = 0; qi < 4; ++qi) { const int q = 4 * w + qi, t = t0 + q; const unsigned plen = ST[q * 8 + 1];
        if (plen == DS_SELALL) { for (int i = lane; i <= t; i += 64) OIDX[q * 256 + i] = (unsigned short)i; if (lane == 0) ST[q * 8 + 3] = (unsigned)(t + 1); continue; }
        const unsigned thr1 = ST[q * 8 + 6]; const unsigned h0 = thresh_half((int)thr1 - 1), h1 = thresh_half((int)thr1);
        const unsigned nh0 = (h0 ^ 0x8000u) * 0x10001u; const half2_t nh0v = __builtin_bit_cast(half2_t, nh0);
        const unsigned short* row = scr + q * 8192 + lane * 8; const int nr = (t >> 9) + 1;
        unsigned cnt = 0u;
        for (int r0 = 0; r0 < nr; r0 += RD) {
#pragma unroll
          for (int u = 0; u < RD; ++u) { const int r = r0 + u; if (r < nr) { const u32x4 cur = buf[u]; if (r + RD < nr) buf[u] = *(const u32x4*)(row + (r + RD) * 512);
            const unsigned idx0 = (unsigned)(r * 512 + lane * 8);
            unsigned x[4];
#pragma unroll
            for (int k = 0; k < 4; ++k) { const unsigned ck = cur[k]; x[k] = __builtin_bit_cast(unsigned, __builtin_bit_cast(half2_t, ck) + nh0v); }
            const unsigned f01 = __builtin_amdgcn_perm(x[1], x[0], 0x07050301u) & 0x80808080u, f23 = __builtin_amdgcn_perm(x[3], x[2], 0x07050301u) & 0x80808080u;
            unsigned pm = (f01 | (f23 >> 1)) ^ 0xC0C0C0C0u;
            if (r == nr - 1) { const int nv = t - (int)idx0 + 1, na = nv < 0 ? 0 : (nv > 4 ? 4 : nv), nb = nv - 4 < 0 ? 0 : (nv - 4 > 4 ? 4 : nv - 4);
                pm &= (0x80808080u & (unsigned)((1ull << (8 * na)) - 1ull)) | (0x40404040u & (unsigned)((1ull << (8 * nb)) - 1ull)); }
            const unsigned c = (unsigned)__builtin_popcount(pm); const unsigned inc = wave_incl_scan(c);
            unsigned base = cnt + inc - c; cnt += __builtin_amdgcn_readlane(inc, 63);
            while (pm) { const unsigned b = (unsigned)__builtin_ctz(pm); pm &= pm - 1u; const unsigned k = b >> 3, hq = (~b) & 1u;
                const unsigned long long pr = hq ? (((unsigned long long)cur[3] << 32) | cur[2]) : (((unsigned long long)cur[1] << 32) | cur[0]);
                const unsigned e = ((unsigned)(pr >> (16u * k)) << 16) | (idx0 + k + 4u * hq);
                if (base < 1024u) LIST[base] = e; ++base; }
          } } }
        if (qi < 3) { const unsigned short* rown = row + 8192; const int nrn = ((t + 1) >> 9) + 1;
#pragma unroll
            for (int u = 0; u < RD; ++u) if (u < nrn) buf[u] = *(const u32x4*)(rown + u * 512); }
        LDS_WAIT();
        const float h1f = (float)__builtin_bit_cast(_Float16, (unsigned short)h1); const unsigned n = cnt < 1024u ? cnt : 1024u; unsigned nsel = 0u, ncand = 0u;
        for (unsigned i0 = 0; i0 < n; i0 += 64u) { const unsigned i = i0 + (unsigned)lane; const bool in = i < n; const unsigned e = in ? LIST[i] : 0u;
            const float sr = (float)__builtin_bit_cast(_Float16, (unsigned short)(e >> 16)); const bool sel = in && sr >= h1f, cd = in && !(sr >= h1f);
            const unsigned long long m = __ballot((int)sel), mc = __ballot((int)cd);
            if (sel) { const unsigned slot = nsel + __builtin_amdgcn_mbcnt_hi((unsigned)(m >> 32), __builtin_amdgcn_mbcnt_lo((unsigned)m, 0u)); if (slot < 256u) OIDX[q * 256 + slot] = (unsigned short)(e & 8191u); }
            if (cd) { const unsigned slot = ncand + __builtin_amdgcn_mbcnt_hi((unsigned)(mc >> 32), __builtin_amdgcn_mbcnt_lo((unsigned)mc, 0u));
                if (slot < DS_CAP) CANDW[slot] = ((unsigned long long)f2key(sr) << 13) | (unsigned long long)(8191u - (e & 8191u)); }
            nsel += (unsigned)__popcll(m); ncand += (unsigned)__popcll(mc); }
        if (lane == 0) { ST[q * 8 + 3] = nsel; ST[q * 8 + 4] = ncand; }
        LDS_WAIT();
        dsa_resolve(L, CANDW, q, lane);
        LDS_WAIT();
    }
}

__device__ __forceinline__ void dsa_tile(const Frame& F, unsigned char* ws, int b, int tile) {
    LAS unsigned char* L = F.lds; const int tid = opq(F.tid), lane = tid & 63, w = F.wave;
    const int t0 = tile * 32; const size_t tokbase = (size_t)b * SEQ + t0;
    const bf16_t* QI = (const bf16_t*)(ws + WS_QI); const bf16_t* KI = (const bf16_t*)(ws + WS_KIDXN) + (size_t)b * SEQ * 64; const float* WIDX = (const float*)(ws + WS_WIDX);
    const bf16_t* QL = (const bf16_t*)(ws + WS_QL); const bf16_t* CKV = (const bf16_t*)(ws + WS_CKVN) + (size_t)b * SEQ * 128; bf16_t* A1 = (bf16_t*)(ws + WS_A1);
    LAS unsigned* HIST = (LAS unsigned*)(L + DS_HIST); LAS unsigned* ST = (LAS unsigned*)(L + DS_ST); LAS float* WQ = (LAS float*)(L + DS_WQ);
    LAS unsigned short* OIDX = (LAS unsigned short*)(L + DS_OIDX); LAS unsigned long long* CAND = (LAS unsigned long long*)(L + DS_HIST); LAS unsigned* PEND = (LAS unsigned*)(L + DS_PEND);
    unsigned short* scr = (unsigned short*)(ws + WS_SCR + (size_t)opq_s((int)blockIdx.x) * 524288);
    if (tid < 256) WQ[tid] = WIDX[tokbase * 8 + tid];
    if (tid < 8) PEND[tid] = 0u;
    LDS_BAR();
    if (tid < 32) { const bool selall = (t0 + tid + 1) <= 256; ST[tid * 8 + 0] = 0u; ST[tid * 8 + 1] = selall ? DS_SELALL : 0u; ST[tid * 8 + 2] = 256u; ST[tid * 8 + 3] = 0u; ST[tid * 8 + 4] = 0u; ST[tid * 8 + 5] = selall ? 1u : 0u; ST[tid * 8 + 6] = 0u;
        if (!selall) lds_or(&PEND[0], 1u); }
    {
      const int q = tid >> 4, d0 = (tid & 15) * 4; f32x4 acc4 = (f32x4){0.f, 0.f, 0.f, 0.f};
#pragma unroll
      for (int hh = 0; hh < 8; ++hh) { const u32x2 v = *(const u32x2*)(QI + (tokbase + q) * 512 + hh * 64 + d0); const float wv = WQ[q * 8 + hh];
          acc4[0] += wv * bflo(v.x); acc4[1] += wv * bfhi(v.x); acc4[2] += wv * bflo(v.y); acc4[3] += wv * bfhi(v.y); }
      *(LAS u32x2*)(L + DS_QBAR + q * 128 + d0 * 2) = pack4(acc4); }
#pragma unroll
    for (int j = 0; j < 16; ++j) *(LAS u32x4*)(L + DS_HIST + (size_t)(tid + 512 * j) * 16) = (u32x4){0u, 0u, 0u, 0u};
    bf16x8 afr[4][4];
    { const int h2 = lane >> 5, rho = lane & 31, ql = 2 * ((rho >> 2) & 1) + (rho >> 4), hd = 4 * ((rho >> 3) & 1) + (rho & 3);
#pragma unroll
      for (int mt = 0; mt < 4; ++mt)
#pragma unroll
          for (int ks = 0; ks < 4; ++ks) afr[mt][ks] = *(const bf16x8*)(QI + (tokbase + 4 * ((w >> 2) * 4 + mt) + ql) * 512 + hd * 64 + 16 * ks + 8 * h2); }
    LDS_BAR();
    const LAS unsigned char* alin;
    { const int h2 = lane >> 5, rho = lane & 15, hq = (rho >> 2) & 1, r = 4 * (rho >> 3) + (rho & 3), qq = 4 * ((w >> 2) * 4 + (r >> 1)) + 2 * hq + (r & 1); alin = L + DS_QBAR + qq * 128 + 16 * h2; }
    for (int lvl = 0; lvl < 4; ++lvl) {
        if (PEND[lvl] == 0u) break;
        if (lvl == 0) dsa_pass<0, true>(afr, alin, KI, t0, L, w, lane, 0, scr); else dsa_pass<0, false>(afr, alin, KI, t0, L, w, lane, lvl, scr);
#if DSA_DUP & 4
        if (lvl == 0) { LDS_BAR();
#pragma unroll
            for (int j = 0; j < 16; ++j) *(LAS u32x4*)(L + DS_HIST + (size_t)(tid + 512 * j) * 16) = (u32x4){0u, 0u, 0u, 0u};
            LDS_BAR(); dsa_pass<0, true>(afr, alin, KI, t0, L, w, lane, 0, scr); }
#endif
        WG_BAR();
        for (int qi = 0; qi < 4; ++qi) { const int q = 4 * w + qi;
            if (ST[q * 8 + 5] == 0u) { const unsigned plen = ST[q * 8 + 1], need = ST[q * 8 + 2], prefix = ST[q * 8 + 0];
                unsigned cnt = 0;
#pragma unroll
                for (int j = 0; j < 4; ++j) { const u32x4 v = *(const LAS u32x4*)(HIST + q * 1024 + lane * 16 + 4 * j);
                    cnt += (v.x & 0xffffu) + (v.x >> 16) + (v.y & 0xffffu) + (v.y >> 16) + (v.z & 0xffffu) + (v.z >> 16) + (v.w & 0xffffu) + (v.w >> 16); }
                const unsigned pre = wave_incl_scan(cnt), tot = (unsigned)__builtin_amdgcn_readlane((int)pre, 63);
                const unsigned s = tot - pre + cnt;
                const unsigned excl = s - cnt;
                if (excl < need && need <= s) { unsigned run = excl, thr = lane * 32, cin = 0;
                    for (int bin = lane * 32 + 31; bin >= lane * 32; --bin) { const unsigned cw = HIST[q * 1024 + (bin >> 1)], cb = (bin & 1) ? (cw >> 16) : (cw & 0xffffu);
                        if (run + cb >= need) { thr = bin; cin = cb; break; } run += cb; }
                    bool d;
                    if (lvl == 0) { ST[q * 8 + 6] = thr + 1u; d = cin <= DS_CAP; }
                    else { const unsigned nbits = lvl < 3 ? 11u : 10u, np = plen + nbits; d = (cin <= DS_CAP) || (np >= 32u); ST[q * 8 + 0] = (prefix << nbits) | thr; ST[q * 8 + 1] = np; }
                    ST[q * 8 + 2] = need - run; ST[q * 8 + 5] = d ? 1u : 0u;
                    if (!d) lds_or(&PEND[lvl + 1], 1u); }
            }
            LDS_WAIT();
#pragma unroll
            for (int j = 0; j < 4; ++j) *(LAS u32x4*)(HIST + q * 1024 + lane * 16 + 4 * j) = (u32x4){0u, 0u, 0u, 0u};
        }
        LDS_BAR();
    }
#if DSA_DUP & 2
    if (PEND[1] == 0u) dsa_emit_stored(scr, t0, L, w, opq(lane));
#endif
    if (PEND[1] == 0u) dsa_emit_stored(scr, t0, L, w, lane);
    else { dsa_pass<1, false>(afr, alin, KI, t0, L, w, lane, 0, scr); LDS_BAR();
        for (int qi = 0; qi < 4; ++qi) dsa_resolve(L, CAND + (4 * w + qi) * 512, 4 * w + qi, lane); }
    LDS_WAIT();
    LAS unsigned char* KVb = L + DS_HIST + w * 16384;
    const int lane0a = lane;
    {
        const int head = lane0a & 7;
        int gq = 0, gk = 0, cq = 0, ck = 0;
#define DSA_NS(qi_) ({ unsigned n_ = ST[(4 * w + (qi_)) * 8 + 3]; n_ = n_ < 256u ? n_ : 256u; (unsigned)__builtin_amdgcn_readfirstlane((int)n_); })
#define DSA_ADV(q_, k_) do { const unsigned nn_ = DSA_NS(q_); if ((unsigned)(64 * ((k_) + 1)) < nn_) ++(k_); else { ++(q_); (k_) = 0; } } while (0)
#define DSA_GATHER(buf_) do { const int lg_ = opq(lane0a); const int q_ = 4 * w + gq; const unsigned ns_ = DSA_NS(gq); _Pragma("unroll") for (int jj = 0; jj < 16; ++jj) { const int pc = lg_ + 64 * jj, row = pc >> 4, ch = pc & 15; \
            const unsigned slot = 64 * gk + row; const unsigned kidx = slot < ns_ ? (unsigned)OIDX[q_ * 256 + slot] : 0u; buf_[jj] = *(const u32x4*)(CKV + (size_t)kidx * 128 + ch * 8); } DSA_ADV(gq, gk); } while (0)
        u32x4 tA[16], tB[16];
        bf16x8 bq[4]; float m_run = -1.0e30f, l_part = 0.f; f32x4 O[8];
        DSA_GATHER(tA);
        if (gq < 4) DSA_GATHER(tB);
        { const int g0 = lane0a >> 4;
#pragma unroll
          for (int ks = 0; ks < 4; ++ks) bq[ks] = *(const bf16x8*)(QL + (tokbase + 4 * w) * 1024 + head * 128 + 32 * ks + 8 * g0); }
        auto chunk = [&](const u32x4 (&buf)[16], bool more) {
            const int lane = opq(lane0a), g = lane >> 4, n16 = lane & 15;
            const int q = 4 * w + cq; const size_t tok = tokbase + q; const unsigned nsel = DSA_NS(cq); const int kc = ck;
            const bool lastc = (unsigned)(64 * (kc + 1)) >= nsel;
            (void)more;
            if (kc == 0) { m_run = -1.0e30f; l_part = 0.f;
#pragma unroll
                for (int mt = 0; mt < 8; ++mt) O[mt] = (f32x4){0.f, 0.f, 0.f, 0.f}; }
            f32x4 sc[4]; float cmax = -1.0e30f;
#pragma unroll
            for (int jt = 0; jt < 4; ++jt) { sc[jt] = (f32x4){0.f, 0.f, 0.f, 0.f};
#pragma unroll
                for (int ks = 0; ks < 4; ++ks) { const bf16x8 A = *(const LAS bf16x8*)(KVb + off_b(16 * jt + n16, 4 * ks + g)); sc[jt] = MFMA16(A, bq[ks], sc[jt]); }
#pragma unroll
                for (int i = 0; i < 4; ++i) { const unsigned slot = 64 * kc + 16 * jt + 4 * g + i; if (slot >= nsel) sc[jt][i] = -1.0e30f; cmax = fmaxf(cmax, sc[jt][i]); } }
            if (lastc && cq < 3) {
#pragma unroll
                for (int ks = 0; ks < 4; ++ks) bq[ks] = *(const bf16x8*)(QL + (tok + 1) * 1024 + (n16 & 7) * 128 + 32 * ks + 8 * g); }
            cmax = max_fq(cmax);
            const float m_new = fmaxf(m_run, cmax), alpha = fast_exp2((m_run - m_new) * 1.4426950408889634f); float ps = 0.f;
#pragma unroll
            for (int jt = 0; jt < 4; ++jt)
#pragma unroll
                for (int i = 0; i < 4; ++i) { const float p = fast_exp2((sc[jt][i] - m_new) * 1.4426950408889634f); sc[jt][i] = p; ps += p; }
            l_part = l_part * alpha + ps; m_run = m_new;
            bf16x8 Pf[2];
#pragma unroll
            for (int k2 = 0; k2 < 2; ++k2) Pf[k2] = __builtin_bit_cast(bf16x8, pack8(sc[2 * k2], sc[2 * k2 + 1]));
#pragma unroll
            for (int mt = 0; mt < 8; ++mt) { O[mt] = O[mt] * alpha;
#pragma unroll
                for (int k2 = 0; k2 < 2; ++k2) { const bf16x8 A = mk8(tr_blk(KVb, 32 * k2 + 4 * g, mt, lane), tr_blk(KVb, 32 * k2 + 16 + 4 * g, mt, lane)); O[mt] = MFMA16(A, Pf[k2], O[mt]); } }
            if (lastc) { const float inv = fast_rcp(red_fq(l_part));
                if (n16 < 8) {
#pragma unroll
                    for (int mt = 0; mt < 8; ++mt) *(u32x2*)(A1 + tok * 1536 + (n16 & 7) * 128 + 16 * mt + 4 * g) = pack4(O[mt] * inv); } }
            DSA_ADV(cq, ck);
        };
#define DSA_STAGE(buf_) do { const int ls_ = opq(lane0a); _Pragma("unroll") for (int jj = 0; jj < 16; ++jj) { const int pc = ls_ + 64 * jj, row = pc >> 4, ch = pc & 15; *(LAS u32x4*)(KVb + off_b(row, ch)) = buf_[jj]; } } while (0)
        for (;;) {
            DSA_STAGE(tA); if (gq < 4) DSA_GATHER(tA); chunk(tA, true); if (cq >= 4) break;
            DSA_STAGE(tB); if (gq < 4) DSA_GATHER(tB); chunk(tB, true); if (cq >= 4) break;
        }
#undef DSA_STAGE
#undef DSA_GATHER
#undef DSA_ADV
#undef DSA_NS
    }
    LDS_BAR();
}

#define NOINL __forceinline__
__device__ __forceinline__ Frame mk_frame(LAS unsigned char* lds) { Frame F; F.lds = lds; int t_ = threadIdx.x; asm volatile("" : "+v"(t_)); F.tid = t_; F.lane = F.tid & 63; F.wave = __builtin_amdgcn_readfirstlane(F.tid >> 6);
    F.G = gridDim.x; F.gw = blockIdx.x * NWAVES + F.wave; F.NGW = F.G * NWAVES; return F; }
__device__ NOINL void ph_prologue(LAS unsigned char* lds, unsigned char* ws) { const Frame F = mk_frame(lds); p0_prologue(F, ws); }
__device__ NOINL void ph_gemm_bf(LAS unsigned char* lds, unsigned char* ws, int which, int Gs, int cs_, int aux) {
    const int cs = opq_s(cs_);
    pg8::Gemm g; pg8::StaticOrder S; EpiBf E; E.split_pn = 99; E.O2 = nullptr; E.ldc2 = 0; E.rsv = nullptr; E.rs_mode = 0; E.pn_stride = 256;
    if (which == 0 || which == 7) { g = pg8::plain_gemm((const bf16_t*)(ws + WS_MEMB), (const bf16_t*)(ws + (which == 0 ? WS_W_XKT : WS_W_XVT)), 1024); S.init(8, 8, Gs, cs);
        E.O = (bf16_t*)(ws + (which == 0 ? WS_KM : WS_VT)); E.ldc = 2048; E.rsv = (const float*)(ws + WS_MEMRS); E.rs_mode = 2; }
    else if (which == 5) { g = pg8::plain_gemm((const bf16_t*)(ws + WS_CQN), (const bf16_t*)(ws + WS_W_Q1T), 256); if (Gs < 0) S.init_panel(6, cs); else S.init(256, 6, Gs, cs); E.O = (bf16_t*)(ws + WS_QL); E.ldc = 1024; E.split_pn = 4; E.O2 = (bf16_t*)(ws + WS_QI); E.ldc2 = 512; }
    else if (which == 6) { g = pg8::plain_gemm((const bf16_t*)(ws + WS_XB), (const bf16_t*)(ws + WS_W_IN1T), 1024); if (Gs < 0) S.init_panel(6, cs); else S.init(256, 6, Gs, cs); E.O = (bf16_t*)(ws + WS_P1RAW); E.ldc = 1536; E.rsv = (const float*)(ws + WS_RSP) + (size_t)3 * M * 4; E.rs_mode = 1; }
    else if (which == 8) { const int L = aux >> 2, h = aux & 3;
        g.A = (const bf16_t*)(ws + WS_KM) + (size_t)L * 1024 + h * 256; g.lda = 2048; g.a_pm = (size_t)256 * 2048 * 2; g.a_pn = 0;
        g.Bt = (const bf16_t*)(ws + WS_W_XQT) + (size_t)L * D * D + h * 256; g.ldb = 1024; g.b_pn = (size_t)256 * 1024 * 2; g.b_pm = 0; g.b_sh = 0; g.K = 256; S.init(8, 4, Gs, cs);
        E.O = (bf16_t*)(ws + WS_WQK) + (size_t)h * 2048 * 1024; E.ldc = 1024; }
    else { const int L = aux >> 2, h = aux & 3;
        g.A = (const bf16_t*)(ws + WS_W_XOT) + (size_t)L * D * D + h * 256; g.lda = 1024; g.a_pm = (size_t)256 * 1024 * 2; g.a_pn = 0;
        g.Bt = (const bf16_t*)(ws + WS_VT) + (size_t)L * 1024 + h * 256; g.ldb = 2048; g.b_pn = (size_t)256 * 2048 * 2; g.b_pm = 0; g.b_sh = 0; g.K = 256; S.init(4, 8, Gs, cs);
        E.O = (bf16_t*)(ws + WS_VWOT) + h * 256; E.ldc = 1024; E.pn_stride = 1024 * 1024; }
    pg8::gemm_phase(lds, g, S, E);
}
__device__ NOINL void ph_gemm_res(LAS unsigned char* lds, unsigned char* ws, float* out, const float* xin, int which) {
    pg8::Gemm g; pg8::StaticOrder S; if (which == 5 && gridDim.x == 256) S.init_panel(4, opq_s((int)blockIdx.x)); else S.init(256, 4, (int)gridDim.x, opq_s((int)blockIdx.x)); int slot;
    if (which == 0) { g = pg8::plain_gemm((const bf16_t*)(ws + (DBG_A0SRC == 1 ? WS_XB : WS_A0)), (const bf16_t*)(ws + WS_W_OUT0T), 1024); slot = 1;
        if (DBG_A0SRC == 2) { g.A += 512; g.K = 512; } if (DBG_A0SRC == 3) { g.K = 512; } }
    else if (which == 1) { g = pg8::plain_gemm((const bf16_t*)(ws + WS_A1), (const bf16_t*)(ws + WS_W_OUT1T), 1536); slot = 4; }
    else if (which <= 3) { const int L = which - 2; g = pg8::plain_gemm((const bf16_t*)(ws + WS_P), (const bf16_t*)(ws + WS_VWOT), 1024); g.b_pm = (size_t)1024 * 1024 * 2; g.b_sh = 5; slot = L ? 5 : 2; }
    else { const int L = which - 4; g = pg8::plain_gemm((const bf16_t*)(ws + WS_ACT), (const bf16_t*)(ws + WS_W_2T) + (size_t)L * D * FF, FF); slot = L ? 6 : 3; }
    (void)out; (void)xin; EpiRes E{(bf16_t*)(ws + WS_XB), (float*)(ws + WS_RSP) + (size_t)slot * M * 4}; pg8::gemm_phase(lds, g, S, E);
}
__device__ NOINL void ph_gemm_in0(LAS unsigned char* lds, unsigned char* ws) {
    pg8::Gemm g = pg8::plain_gemm((const bf16_t*)(ws + WS_XB), (const bf16_t*)(ws + WS_W_IN0T), 1024); pg8::StaticOrder S; S.init(256, 14, (int)gridDim.x, opq_s((int)blockIdx.x));
    EpiIn0 E{ws};
    pg8::gemm_phase(lds, g, S, E);
}
__device__ NOINL void ph_gemm_s(LAS unsigned char* lds, unsigned char* ws, int L) {
    pg8::Gemm g = pg8::plain_gemm((const bf16_t*)(ws + WS_XB), (const bf16_t*)(ws + WS_WQK), 1024); g.b_pn = (size_t)8 * 256 * 1024 * 2; g.b_pm = (size_t)256 * 1024 * 2; g.b_sh = 5;
    pg8::StaticOrder S; S.init(256, 4, (int)gridDim.x, opq_s((int)blockIdx.x));
    EpiS E{(bf16_t*)(ws + WS_P), (const float*)(ws + WS_RSP) + (size_t)(L ? 4 : 1) * M * 4}; pg8::gemm_phase(lds, g, S, E);
}
__device__ NOINL void ph_gemm_ffn1(LAS unsigned char* lds, unsigned char* ws, int L) {
    pg8::Gemm g = pg8::plain_gemm((const bf16_t*)(ws + WS_XB), (const bf16_t*)(ws + WS_W_13T) + (size_t)L * 5632 * D, 1024); pg8::StaticOrder S; S.init(256, 22, (int)gridDim.x, opq_s((int)blockIdx.x));
    EpiFfn1 E{(bf16_t*)(ws + WS_ACT), (const float*)(ws + WS_RSP) + (size_t)(L ? 5 : 2) * M * 4}; pg8::gemm_phase(lds, g, S, E);
}

__device__ NOINL void ph_post1(LAS unsigned char* lds, unsigned char* ws, int row0, int nrows) { const Frame F = mk_frame(lds);
    const bf16_t* P1 = (const bf16_t*)(ws + WS_P1RAW); bf16_t* CQN = (bf16_t*)(ws + WS_CQN); bf16_t* CKVN = (bf16_t*)(ws + WS_CKVN); bf16_t* KIDXN = (bf16_t*)(ws + WS_KIDXN); float* WIDX = (float*)(ws + WS_WIDX);
    bf16_t* U = (bf16_t*)(ws + WS_U); bf16_t* DVN = (bf16_t*)(ws + WS_DV);
    const int lane = F.lane; const bool is_cq = lane < 32, is_kv = lane >= 32 && lane < 48, is_ki = lane >= 48 && lane < 56, is_w = lane == 56;
    float g0[8], b0[8], vg[8], vb[8];
#pragma unroll
    for (int i = 0; i < 8; ++i) { g0[i] = is_kv ? INP(I_OCKVN)[(lane - 32) * 8 + i] : (is_ki ? INP(I_OIDXKG)[(lane - 48) * 8 + i] : 1.f); b0[i] = is_ki ? INP(I_OIDXKB)[(lane - 48) * 8 + i] : 0.f;
        vg[i] = INP(I_ODVG)[lane * 8 + i]; vb[i] = INP(I_ODVB)[lane * 8 + i]; }
    const int rstep = (nrows == M ? F.NGW : NWAVES), rfirst = row0 + (nrows == M ? F.gw : F.wave);
    u32x4 nx0, nx1, nx2;
    if (rfirst < row0 + nrows) { const bf16_t* pr = P1 + (size_t)rfirst * 1536; nx0 = *(const u32x4*)(pr + lane * 8); nx1 = *(const u32x4*)(pr + 512 + lane * 8); nx2 = *(const u32x4*)(pr + 1024 + lane * 8); }
    for (int row = rfirst; row < row0 + nrows; row += rstep) {
        const u32x4 c0 = nx0, c1 = nx1, c2 = nx2;
        if (row + rstep < row0 + nrows) { const bf16_t* pr = P1 + (size_t)(row + rstep) * 1536; nx0 = *(const u32x4*)(pr + lane * 8); nx1 = *(const u32x4*)(pr + 512 + lane * 8); nx2 = *(const u32x4*)(pr + 1024 + lane * 8); }
        float x0[8], x1[8], x2[8]; unpack8(c0, x0); unpack8(c1, x1); unpack8(c2, x2);
        float s0 = 0.f, q0 = 0.f, s2 = 0.f, q2 = 0.f;
#pragma unroll
        for (int i = 0; i < 8; ++i) { s0 += x0[i]; q0 += x0[i] * x0[i]; x1[i] = gelu_f(x1[i]); x2[i] = gelu_f(x2[i]); s2 += x2[i]; q2 += x2[i] * x2[i]; }
        const float ss_cq = wave_sum(is_cq ? q0 : 0.f), ss_kv = wave_sum(is_kv ? q0 : 0.f), s_ki = wave_sum(is_ki ? s0 : 0.f), q_ki = wave_sum(is_ki ? q0 : 0.f);
        s2 = wave_sum(s2); q2 = wave_sum(q2);
        const float mean_ki = s_ki * (1.0f / 64.f), var_ki = q_ki * (1.0f / 64.f) - mean_ki * mean_ki;
        const float sc0 = is_cq ? fast_rsq(ss_cq * (1.0f / 256.f) + 1e-6f) : (is_kv ? fast_rsq(ss_kv * (1.0f / 128.f) + 1e-6f) : (is_ki ? fast_rsq(fmaxf(var_ki, 0.f) + 1e-5f) : 0.35355339059327373f));
        const float sub0 = is_ki ? mean_ki : 0.f;
#pragma unroll
        for (int i = 0; i < 8; ++i) x0[i] = (x0[i] - sub0) * sc0 * g0[i] + b0[i];
        if (is_cq) *(u32x4*)(CQN + (size_t)row * 256 + lane * 8) = pack8f(x0);
        else if (is_kv) *(u32x4*)(CKVN + (size_t)row * 128 + (lane - 32) * 8) = pack8f(x0);
        else if (is_ki) *(u32x4*)(KIDXN + (size_t)row * 64 + (lane - 48) * 8) = pack8f(x0);
        else if (is_w) { *(f32x4*)(WIDX + (size_t)row * 8) = (f32x4){x0[0], x0[1], x0[2], x0[3]}; *(f32x4*)(WIDX + (size_t)row * 8 + 4) = (f32x4){x0[4], x0[5], x0[6], x0[7]}; }
        *(u32x4*)(U + (size_t)row * 512 + lane * 8) = pack8f(x1);
        const float mean2 = s2 * (1.0f / 512.f), var2 = q2 * (1.0f / 512.f) - mean2 * mean2, rstd2 = fast_rsq(fmaxf(var2, 0.f) + 1e-5f);
#pragma unroll
        for (int i = 0; i < 8; ++i) x2[i] = (x2[i] - mean2) * rstd2 * vg[i] + vb[i];
        *(u32x4*)(DVN + (size_t)row * 512 + lane * 8) = pack8f(x2);
    }
}
__device__ NOINL void ph_hgrn(LAS unsigned char* lds, unsigned char* ws, int unit) { const Frame F = mk_frame(lds); hgrn_unit(F, ws, unit); }
__device__ NOINL void ph_hgrnA(LAS unsigned char* lds, unsigned char* ws, int unit) { const Frame F = mk_frame(lds); hgrn_passA(F, ws, unit); }
__device__ NOINL void ph_conv(LAS unsigned char* lds, unsigned char* ws, int wg, int nwg) { const Frame F = mk_frame(lds); conv_part(F, ws, wg, nwg); }
__device__ NOINL void ph_fin(LAS unsigned char* lds, unsigned char* ws) { const Frame F = mk_frame(lds); hgrn_finalize(F, ws); }
__device__ NOINL void ph_gmlp(LAS unsigned char* lds, unsigned char* ws, int panel) { const Frame F = mk_frame(lds);
    if (panel >= 0) { for (int k = 0; k < 8; ++k) gmlp_unit(F, ws, 8 * panel + k); } else for (int u = blockIdx.x; u < 2048; u += F.G) gmlp_unit(F, ws, u); }
__device__ NOINL void ph_dsa(LAS unsigned char* lds, unsigned char* ws) { const Frame F = mk_frame(lds);
    for (int tl = blockIdx.x; tl < 2048; tl += F.G) { const int b = tl & 7, idx = tl >> 3, i = idx >> 5, j = idx & 31; dsa_tile(F, ws, b, (i & 1) ? 32 * i + 31 - j : 32 * i + j); } }
__device__ NOINL void ph_final(LAS unsigned char* lds, unsigned char* ws, float* out, int slot, int row0, int nrows) { const Frame F = mk_frame(lds);
    const float* rsp = (const float*)(ws + WS_RSP) + (size_t)slot * M * 4; const float* fg = INP(I_FINAL);
    f32x4 gv[4];
#pragma unroll
    for (int j = 0; j < 4; ++j) gv[j] = *((const f32x4*)fg + F.lane + 64 * j);
    const int rstep = (nrows == M ? F.NGW : NWAVES), rfirst = row0 + (nrows == M ? F.gw : F.wave);
    f32x4 np; u32x2 nx[4];
    if (rfirst < row0 + nrows) { np = *(const f32x4*)(rsp + (size_t)rfirst * 4); const u32x2* xs = (const u32x2*)((const bf16_t*)(ws + WS_XB) + (size_t)rfirst * D) + F.lane;
#pragma unroll
        for (int j = 0; j < 4; ++j) nx[j] = xs[64 * j]; }
    for (int row = rfirst; row < row0 + nrows; row += rstep) { const f32x4 p = np; u32x2 cx4[4];
#pragma unroll
        for (int j = 0; j < 4; ++j) cx4[j] = nx[j];
        if (row + rstep < row0 + nrows) { np = *(const f32x4*)(rsp + (size_t)(row + rstep) * 4); const u32x2* xs = (const u32x2*)((const bf16_t*)(ws + WS_XB) + (size_t)(row + rstep) * D) + F.lane;
#pragma unroll
            for (int j = 0; j < 4; ++j) nx[j] = xs[64 * j]; }
        const float rs = fast_rsq(((p[0] + p[1]) + (p[2] + p[3])) * (1.0f / 1024.f) + 1e-6f);
        f32x4* xr = (f32x4*)(out + (size_t)row * D) + F.lane;
#pragma unroll
        for (int j = 0; j < 4; ++j) { const u32x2 xo = cx4[j]; xr[64 * j] = (f32x4){bflo(xo.x), bfhi(xo.x), bflo(xo.y), bfhi(xo.y)} * rs * gv[j]; } }
}

constexpr int N_PHASES = 23;

#ifndef PH_MASK
#define PH_MASK 0xffffffffu
#endif
#define EN(k) (((PH_MASK) >> (k)) & 1u)
#ifndef DUP_MASK
#define DUP_MASK 0x0u
#endif
#define DUP(k) (((DUP_MASK) >> (k)) & 1u)
__global__ void __launch_bounds__(NTHR, 2) mk_fwd(Args args) {
    extern __shared__ __attribute__((aligned(16))) unsigned char lds_raw[];
    LAS unsigned char* lds = (LAS unsigned char*)lds_raw;
#define KARG ((const volatile __attribute__((address_space(4))) Args*)__builtin_amdgcn_kernarg_segment_ptr())
#define ws ((unsigned char*)KARG->ws)
#define out ((float*)KARG->out)
    const int G = gridDim.x, bx = blockIdx.x, tid = threadIdx.x;
    volatile LAS unsigned* MISC = (volatile LAS unsigned*)(lds + MISC_OFF);
    if (tid < 64) MISC[tid] = 0u;
    if (tid < 32) *(const float* LAS*)(lds + PTAB_OFF + 8 * tid) = args.in[tid];
    __syncthreads();
#if MK_N_LAUNCHES == 1
    (void)xcd_barrier_post((unsigned*)(ws + WS_CTL) + CW_BAR, MISC + 8);
#define GRID_BAR() do { XcdBarrier b_; unsigned char* wso_ = ws; b_.bar = (unsigned*)(wso_ + WS_CTL) + CW_BAR; b_.x = xb_xcc_id(); b_.st = (volatile LAS unsigned*)(lds + MISC_OFF) + 8; xcd_barrier(b_); } while (0)
#else
#define GRID_BAR() do { } while (0)
#endif
    const int lo = (MK_N_LAUNCHES == 1) ? 0 : args.ph_lo, hi = (MK_N_LAUNCHES == 1) ? N_PHASES : args.ph_hi;
#define IN(k) (lo <= (k) && (k) < hi)
#define SEAM(k) do { if (IN(k) && IN((k) + 1)) GRID_BAR(); } while (0)
    if (EN(0) && IN(0)) { ph_prologue(lds, ws); if (DUP(0)) { GRID_BAR(); ph_prologue(lds, ws); } }
    SEAM(0);
#pragma unroll
    for (int L = 0; L < 2; ++L) {
        if (L == 0) {
            if (EN(1) && IN(1)) { const int half = G / 2; if (EN(23)) { if (bx < half) ph_gemm_bf(lds, ws, 0, half, bx, 0); else ph_gemm_bf(lds, ws, 7, G - half, bx - half, 0); } if (EN(24)) ph_gemm_in0(lds, ws); if (DUP(1)) { GRID_BAR(); ph_gemm_in0(lds, ws); } }
            SEAM(1);
            if (EN(2) && IN(2)) { for (int u = bx; u < 256; u += G) ph_hgrnA(lds, ws, u); ph_conv(lds, ws, bx, G); GRID_BAR(); for (int u = bx; u < 256; u += G) ph_hgrn(lds, ws, u); }
            SEAM(3);
            if (EN(4) && IN(4)) { { const int q4 = G / 4, hh = bx / q4, cc = bx % q4; if (hh < 4) { ph_gemm_bf(lds, ws, 8, q4, cc, hh); ph_gemm_bf(lds, ws, 9, q4, cc, hh); } }
                ph_gemm_res(lds, ws, out, (const float*)KARG->in[I_X], 0); }
            SEAM(4);
        } else {
            if (G == 256) {
                if (IN(11)) { ph_gemm_bf(lds, ws, 6, -1, bx, 0); ph_post1(lds, ws, 256 * bx, 256); WG_BAR(); ph_gemm_bf(lds, ws, 5, -1, bx, 0); ph_gmlp(lds, ws, bx); }
            } else {
            if (EN(11) && IN(11)) ph_gemm_bf(lds, ws, 6, G, bx, 0);
            SEAM(11);
            if (EN(15) && IN(12)) { ph_post1(lds, ws, 0, M); }
            SEAM(12);
            if (EN(12) && IN(13)) { if (EN(25)) ph_gemm_bf(lds, ws, 5, G, bx, 0); if (EN(22)) ph_gmlp(lds, ws, -1); }
            }
            SEAM(13);
            if (EN(13) && IN(14)) { ph_dsa(lds, ws); if (DUP(13)) { GRID_BAR(); ph_dsa(lds, ws); } }
            SEAM(14);
            if (EN(14) && IN(15)) { { const int q4 = G / 4, hh = bx / q4, cc = bx % q4; if (hh < 4) { ph_gemm_bf(lds, ws, 8, q4, cc, 4 + hh); ph_gemm_bf(lds, ws, 9, q4, cc, 4 + hh); } }
                ph_gemm_res(lds, ws, out, out, 1); }
            SEAM(15);
        }
        const int pb = L ? 16 : 5;
        if (EN(6) && IN(pb + 1)) { ph_gemm_s(lds, ws, L); if (DUP(6)) { GRID_BAR(); ph_gemm_s(lds, ws, L); } }
        SEAM(pb + 1);
        if (EN(8) && IN(pb + 3)) ph_gemm_res(lds, ws, out, out, 2 + L);
        SEAM(pb + 3);
        if (EN(9) && IN(pb + 4)) { ph_gemm_ffn1(lds, ws, L); if (DUP(9)) { GRID_BAR(); ph_gemm_ffn1(lds, ws, L); } }
        SEAM(pb + 4);
        if (EN(10) && IN(pb + 5)) ph_gemm_res(lds, ws, out, out, 4 + L);
        if (!(L == 1 && G == 256)) SEAM(pb + 5);
    }
    if (EN(21) && IN(22)) { if (G == 256) ph_final(lds, ws, out, 6, 256 * bx, 256); else ph_final(lds, ws, out, 6, 0, M); }
#undef ws
#undef out
#undef KARG
#undef IN
#undef SEAM
}

extern "C" void kernel_launch(void* const* d_in, const int* in_sizes, int n_in, void* d_out, int out_size, void* d_ws, size_t ws_size, hipStream_t stream) {
    static int grid = 0;
    if (grid == 0) {
        if (n_in != N_IN || in_sizes[0] != M * D || out_size != M * D || ws_size < WS_END) { fprintf(stderr, "kernel_launch: unexpected shapes (n_in %d, in0 %d, out %d, ws %zu)\n", n_in, n_in > 0 ? in_sizes[0] : -1, out_size, ws_size); grid = -1; return; }
        int dev = 0, cus = 0, per_cu = 0;
        if (hipGetDevice(&dev) != hipSuccess || hipDeviceGetAttribute(&cus, hipDeviceAttributeMultiprocessorCount, dev) != hipSuccess) { grid = -1; return; }
        if (hipFuncSetAttribute((const void*)mk_fwd, hipFuncAttributeMaxDynamicSharedMemorySize, LDS_BYTES) != hipSuccess) { fprintf(stderr, "kernel_launch: hipFuncSetAttribute failed\n"); grid = -1; return; }
        if (hipOccupancyMaxActiveBlocksPerMultiprocessor(&per_cu, (const void*)mk_fwd, NTHR, LDS_BYTES) != hipSuccess || per_cu < 1) fprintf(stderr, "kernel_launch: occupancy query reports %d\n", per_cu);
        (void)hipGetLastError();
        grid = cus;
        if (grid != 256) fprintf(stderr, "kernel_launch: %d CUs (built for 256)\n", grid);
    }
    if (grid < 0) return;
    if (hipMemsetAsync((char*)d_ws + WS_CTL, 0, CTL_ZERO_BYTES, stream) != hipSuccess) return;
    Args a{};
    for (int i = 0; i < N_IN; ++i) a.in[i] = (const float*)d_in[i];
    a.out = (float*)d_out; a.ws = (unsigned char*)d_ws; a.fin_slot = TRUNC_SLOT;
#if MK_N_LAUNCHES == 1
    a.ph_lo = 0; a.ph_hi = N_PHASES;
    hipLaunchKernelGGL(mk_fwd, dim3(grid), dim3(NTHR), LDS_BYTES, stream, a);
#else
    for (int p = 0; p < N_PHASES; ++p) { if (!((LAUNCH_MASK >> p) & 1u)) continue; a.ph_lo = p; a.ph_hi = p + 1; hipLaunchKernelGGL(mk_fwd, dim3(grid), dim3(NTHR), LDS_BYTES, stream, a); }
#endif
}
```

```cpp
#include <hip/hip_runtime.h>
#include <cstdio>
#include <cstdint>

#ifndef MK_N_LAUNCHES
#define MK_N_LAUNCHES 1
#endif

#ifndef LAUNCH_MASK
#define LAUNCH_MASK 0x7fffffu
#define TRUNC_SLOT 6
#define DBG_A0SRC 0
#define DBG_FIN_SRC WS_HO
#define HG_DBG 0
#endif
#ifndef DSA_DUP
#define DSA_DUP 0
#endif
#define LAS __attribute__((address_space(3)))
#define GAS __attribute__((address_space(1)))
typedef unsigned short bf16_t;
typedef short bf16x8 __attribute__((ext_vector_type(8)));
typedef short s16x4 __attribute__((ext_vector_type(4)));
typedef float f32x4 __attribute__((ext_vector_type(4)));
typedef float f32x2 __attribute__((ext_vector_type(2)));
typedef float f32x16 __attribute__((ext_vector_type(16)));
typedef unsigned u32x4 __attribute__((ext_vector_type(4)));
typedef unsigned u32x2 __attribute__((ext_vector_type(2)));
typedef GAS unsigned gu32;

constexpr int BATCH = 8, SEQ = 8192, D = 1024, M = BATCH * SEQ;
constexpr int MEMLEN = 256, MROWS = BATCH * MEMLEN;
constexpr int FF = 2816;
constexpr int NIN0 = 3584, NIN1 = 1536;
constexpr int NWAVES = 8, NTHR = 512;

constexpr size_t MiB = 1u << 20;
constexpr size_t WS_CTL = 0, CTL_ZERO_BYTES = 1 * MiB;
constexpr size_t WS_W_IN0T  = 2 * MiB;
constexpr size_t WS_W_OUT0T = WS_W_IN0T + (size_t)NIN0 * D * 2;
constexpr size_t WS_W_IN1T  = WS_W_OUT0T + (size_t)D * D * 2;
constexpr size_t WS_W_Q1T   = WS_W_IN1T + (size_t)NIN1 * D * 2;
constexpr size_t WS_W_OUT1T = WS_W_Q1T + (size_t)1536 * 256 * 2;
constexpr size_t WS_W_XQT   = WS_W_OUT1T + (size_t)D * 1536 * 2;
constexpr size_t WS_W_XKT   = WS_W_XQT + (size_t)2 * D * D * 2;
constexpr size_t WS_W_XVT   = WS_W_XKT + (size_t)2048 * D * 2;
constexpr size_t WS_W_XOT   = WS_W_XVT + (size_t)2048 * D * 2;
constexpr size_t WS_W_13T   = WS_W_XOT + (size_t)2 * D * D * 2;
constexpr size_t WS_W_2T    = WS_W_13T + (size_t)2 * 5632 * D * 2;
constexpr size_t WS_WC      = WS_W_2T + (size_t)2 * D * FF * 2;
constexpr size_t WS_LB      = WS_WC + (size_t)4 * 128 * 128 * 2;
constexpr size_t WS_MEMB    = WS_LB + 4096;
constexpr size_t WS_MEMRS   = WS_MEMB + (size_t)MROWS * D * 2;
constexpr size_t WS_KM      = WS_MEMRS + (size_t)MROWS * 4;
constexpr size_t WS_VT      = WS_KM + (size_t)MROWS * 2048 * 2;
constexpr size_t WS_RSP     = WS_VT + (size_t)2048 * MROWS * 2;
constexpr size_t WS_EBG     = WS_RSP + (size_t)7 * M * 16;
constexpr size_t WS_DVST    = WS_EBG + (size_t)(M / 64) * 512 * 4;
constexpr size_t WS_WIDX    = WS_DVST + (size_t)M * 16;
constexpr size_t WS_SLOC    = WS_WIDX + (size_t)M * 32;
constexpr size_t WS_DSEG    = WS_SLOC + (size_t)256 * 16384 * 4;
constexpr size_t WS_XB      = 124 * MiB;
constexpr size_t WS_BIG1    = 252 * MiB;
constexpr size_t WS_BIG2    = 636 * MiB;
constexpr size_t WS_WQK     = 988 * MiB;
constexpr size_t WS_VWOT    = 1004 * MiB;
constexpr size_t WS_END     = 1020 * MiB;
static_assert(WS_BIG2 + (size_t)M * FF * 2 <= WS_WQK, "ws map");
static_assert(WS_DSEG + (size_t)256 * 128 * 4 <= WS_XB, "ws map");
constexpr size_t T64 = (size_t)M * 512 * 2;
constexpr size_t WS_QE = WS_BIG1, WS_KINV = WS_BIG1 + T64, WS_KDEC = WS_BIG1 + 2 * T64, WS_HV = WS_BIG1 + 3 * T64, WS_HZ = WS_BIG1 + 4 * T64;
constexpr size_t WS_A0 = WS_BIG2, WS_HO = WS_BIG2 + 2 * T64, WS_HG = WS_BIG2 + 3 * T64, WS_HB = WS_BIG2 + 4 * T64;
constexpr size_t WS_P = WS_BIG1, WS_ACT = WS_BIG2;
constexpr size_t WS_CQN = WS_BIG1, WS_CKVN = WS_CQN + (size_t)M * 256 * 2, WS_KIDXN = WS_CKVN + (size_t)M * 128 * 2, WS_U = WS_KIDXN + (size_t)M * 64 * 2,
                 WS_DV = WS_U + T64, WS_QL = WS_DV + T64, WS_QI = WS_QL + 2 * T64, WS_A1 = WS_BIG2, WS_P1RAW = WS_BIG2;
static_assert(WS_QI + T64 <= WS_BIG2, "ws map");
constexpr size_t WS_SCR = WS_BIG2 + 192 * MiB;
static_assert(WS_SCR + (size_t)256 * 524288 <= WS_BIG2 + 384 * MiB, "ws map");

constexpr int CW_TMO = 0;
constexpr int CW_BAR = 4096;

constexpr int RING_BYTES = 131072;
constexpr int XLDS_OFF = RING_BYTES;
constexpr int MISC_OFF = 159744 - 256;
constexpr int PTAB_OFF = 159744 - 512;
constexpr int LDS_BYTES = 159744;

#define RLX_AGENT __ATOMIC_RELAXED, __HIP_MEMORY_SCOPE_AGENT
#define LDS_WAIT() asm volatile("s_waitcnt lgkmcnt(0)" ::: "memory")
#define VM_WAIT() asm volatile("s_waitcnt vmcnt(0)" ::: "memory")
#define WG_BAR() do { asm volatile("s_waitcnt vmcnt(0) lgkmcnt(0)" ::: "memory"); __builtin_amdgcn_s_barrier(); asm volatile("" ::: "memory"); } while (0)
#define LDS_BAR() do { asm volatile("s_waitcnt lgkmcnt(0)" ::: "memory"); __builtin_amdgcn_s_barrier(); asm volatile("" ::: "memory"); } while (0)

typedef __bf16 bf16x2_t __attribute__((ext_vector_type(2)));
__device__ __forceinline__ unsigned cvt_pk_bf16(float lo, float hi) { const f32x2 v = {lo, hi}; return __builtin_bit_cast(unsigned, __builtin_convertvector(v, bf16x2_t)); }
__device__ __forceinline__ u32x2 pack4(f32x4 v) { u32x2 w; w.x = cvt_pk_bf16(v[0], v[1]); w.y = cvt_pk_bf16(v[2], v[3]); return w; }
__device__ __forceinline__ u32x4 pack8(f32x4 a, f32x4 b) { u32x4 w; w.x = cvt_pk_bf16(a[0], a[1]); w.y = cvt_pk_bf16(a[2], a[3]); w.z = cvt_pk_bf16(b[0], b[1]); w.w = cvt_pk_bf16(b[2], b[3]); return w; }
__device__ __forceinline__ float bf2f(unsigned short b) { return __uint_as_float(((unsigned)b) << 16); }
__device__ __forceinline__ float bflo(unsigned w) { return __uint_as_float(w << 16); }
__device__ __forceinline__ float bfhi(unsigned w) { return __uint_as_float(w & 0xffff0000u); }
__device__ __forceinline__ float fast_exp2(float x) { return __builtin_amdgcn_exp2f(x); }
__device__ __forceinline__ float fast_rcp(float x) { return __builtin_amdgcn_rcpf(x); }
__device__ __forceinline__ float fast_rsq(float x) { return __builtin_amdgcn_rsqf(x); }
__device__ __forceinline__ float sigmoid_f(float x) { return fast_rcp(1.0f + fast_exp2(-1.4426950408889634f * x)); }
__device__ __forceinline__ float silu_f(float x) { return x * sigmoid_f(x); }
__device__ __forceinline__ float gelu_f(float v) {
    const float av = __builtin_fabsf(v), t = fast_rcp(av * 0.2316418882f + 1.0f);
    float q = t * 0.5307027145f + (-0.7265760135f); q = q * t + 0.7107068705f; q = q * t + (-0.142248368f); q = q * t + 0.127414796f; q = q * t;
    const float e = fast_exp2((v * v) * (-0.72134752044f));
    const float m = v * (q * e);
    return v < 0.f ? m : v - m;
}
__device__ __forceinline__ int opq(int v) { asm volatile("" : "+v"(v)); return v; }
__device__ __forceinline__ int opq_s(int v) { asm volatile("" : "+s"(v)); return v; }
__device__ __forceinline__ float wave_sum(float v) {
    v += __builtin_bit_cast(float, __builtin_amdgcn_update_dpp(0, __builtin_bit_cast(int, v), 0x111, 0xf, 0xf, true));
    v += __builtin_bit_cast(float, __builtin_amdgcn_update_dpp(0, __builtin_bit_cast(int, v), 0x112, 0xf, 0xf, true));
    v += __builtin_bit_cast(float, __builtin_amdgcn_update_dpp(0, __builtin_bit_cast(int, v), 0x114, 0xf, 0xf, true));
    v += __builtin_bit_cast(float, __builtin_amdgcn_update_dpp(0, __builtin_bit_cast(int, v), 0x118, 0xf, 0xf, true));
    v += __builtin_bit_cast(float, __builtin_amdgcn_update_dpp(0, __builtin_bit_cast(int, v), 0x142, 0xa, 0xf, false));
    v += __builtin_bit_cast(float, __builtin_amdgcn_update_dpp(0, __builtin_bit_cast(int, v), 0x143, 0xc, 0xf, false));
    return __builtin_bit_cast(float, __builtin_amdgcn_readlane(__builtin_bit_cast(int, v), 63));
}

#define XB_TMO      128
#define XB_XCNT(j)  (256  + 64 * (j))
#define XB_XSUB(j)  (1280 + 64 * (j))
#define XB_XGEN(j)  (2304 + 64 * (j))
#define XB_TOP      3328
#define XB_TOPGEN   3392
#define XCD_BAR_WORDS 3456
#define XB_SPIN_CAP (1u << 22)

__device__ __forceinline__ unsigned xb_ld(unsigned* p)              { return __hip_atomic_load(p, __ATOMIC_RELAXED, __HIP_MEMORY_SCOPE_AGENT); }
__device__ __forceinline__ unsigned xb_add(unsigned* p, unsigned v) { return __hip_atomic_fetch_add(p, v, __ATOMIC_RELAXED, __HIP_MEMORY_SCOPE_AGENT); }
__device__ __forceinline__ unsigned xb_xcc_id() { return (unsigned)__builtin_amdgcn_s_getreg((3 << 11) | 20) & 0xFu; }
#define XB_SPIN(cond, bar) do { unsigned _sp = 0; while (cond) { __builtin_amdgcn_s_sleep(1); \
    if ((++_sp & 255u) == 0u) { if (xb_ld(&(bar)[XB_TMO])) break; if (_sp > XB_SPIN_CAP) { atomicAdd(&(bar)[XB_TMO], 1u); break; } } } } while (0)

struct XcdBarrier { unsigned* bar; unsigned x; volatile LAS unsigned* st; };
__device__ __forceinline__ XcdBarrier xcd_barrier_post(unsigned* bar, volatile LAS unsigned* st) {
    XcdBarrier b; b.bar = bar; b.x = xb_xcc_id(); b.st = st;
    if (threadIdx.x == 0) (void)xb_add(&bar[XB_XCNT(b.x)], 1u);
    return b;
}
__device__ __forceinline__ void xcd_barrier_complete(unsigned* bar, unsigned x, unsigned& nloc, unsigned& nx) {
    const unsigned G = gridDim.x * gridDim.y * gridDim.z;
    unsigned sum, cnt, mine, sp = 0u;
    for (;;) {
        sum = 0u; cnt = 0u; mine = 0u;
#pragma unroll
        for (unsigned j = 0; j < 16; ++j) { const unsigned c = xb_ld(&bar[XB_XCNT(j)]); sum += c; cnt += (c > 0u) ? 1u : 0u; mine = (j == x) ? c : mine; }
        if (sum == G) break;
        __builtin_amdgcn_s_sleep(1);
        if ((++sp & 255u) == 0u) { if (xb_ld(&bar[XB_TMO])) break; if (sp > XB_SPIN_CAP) { atomicAdd(&bar[XB_TMO], 1u); break; } }
    }
    nloc = mine > 0u ? mine : 1u; nx = cnt > 0u ? cnt : 1u;
}
__device__ __forceinline__ void xcd_barrier(const XcdBarrier& b) {
    asm volatile("s_waitcnt vmcnt(0)" ::: "memory");
    __syncthreads();
    if (threadIdx.x == 0) {
        unsigned* bar = b.bar;
        __builtin_amdgcn_s_waitcnt(0);
        unsigned nloc = b.st[0], nx = b.st[1];
        if (nloc == 0u) { xcd_barrier_complete(bar, b.x, nloc, nx); b.st[0] = nloc; b.st[1] = nx; }
        const unsigned old = xb_add(&bar[XB_XSUB(b.x)], 1u);
        const unsigned gen = old / nloc;
        if (old + 1u == (gen + 1u) * nloc) {
            __builtin_amdgcn_fence(__ATOMIC_RELEASE, "agent");
            asm volatile("s_waitcnt vmcnt(0)" ::: "memory");
            const unsigned og = xb_add(&bar[XB_TOP], 1u);
            const unsigned tg = og / nx;
            if (og + 1u == (tg + 1u) * nx) xb_add(&bar[XB_TOPGEN], 1u);
            else XB_SPIN(xb_ld(&bar[XB_TOPGEN]) == tg, bar);
            __builtin_amdgcn_fence(__ATOMIC_ACQUIRE, "agent");
            xb_add(&bar[XB_XGEN(b.x)], 1u);
            asm volatile("s_waitcnt vmcnt(0)" ::: "memory");
        } else {
            XB_SPIN(xb_ld(&bar[XB_XGEN(b.x)]) == gen, bar);
            __builtin_amdgcn_fence(__ATOMIC_ACQUIRE, "agent");
            asm volatile("s_waitcnt vmcnt(0)" ::: "memory");
        }
    }
    __syncthreads();
}

namespace pg8 {
constexpr int BM = 256, BK = 64, HALF = 128, HTB = HALF * BK * 2, NXCD = 8, WGM = 8;
__host__ __device__ __forceinline__ int lds_byte(int r, int c) { const int st = (r >> 4) * 2 + (c >> 5), rr = r & 15, cc = c & 31, ob = rr * 64 + cc * 2; return st * 1024 + (ob ^ (((ob >> 9) & 1) << 5)); }
__host__ __device__ __forceinline__ void stage_rc(int b, int& R, int& C) { const int st = b / 1024, sb = b % 1024, swz = sb ^ (((sb >> 9) & 1) << 5); R = (st >> 1) * 16 + swz / 64; C = (st & 1) * 32 + (swz % 64) / 2; }
__host__ __device__ __forceinline__ int perm32(int rho) { const int n = rho >> 4, i = rho & 15; return 8 * (i >> 2) + 4 * n + (i & 3); }
struct Unit { int pm, pn; };
struct Gemm { const bf16_t* A; const bf16_t* Bt; int lda, ldb, K; size_t a_pm, a_pn, b_pn, b_pm; int b_sh; };
__device__ __forceinline__ Gemm plain_gemm(const bf16_t* A, const bf16_t* Bt, int K) { Gemm g; g.A = A; g.Bt = Bt; g.lda = K; g.ldb = K; g.K = K; g.a_pm = (size_t)256 * K * 2; g.a_pn = 0; g.b_pn = (size_t)256 * K * 2; g.b_pm = 0; g.b_sh = 0; return g; }
struct StaticOrder {
    int nM, nN, nwg, G, c;
    __device__ void init(int nM_, int nN_, int G_, int c_) { nM = nM_; nN = nN_; nwg = nM * nN; G = G_; c = c_; }
    __device__ void init_panel(int nN_, int pm_) { nM = 1; nN = nN_; nwg = nN_; G = -1; c = pm_; }
    __device__ bool next(int i, Unit& u) const {
        if (G < 0) { if (i >= nN) return false; u.pm = c; u.pn = (i + (c >> 3)) % nN; return true; }
        const long L = (long)i * G + c; if (L >= nwg) return false;
        int wgid = (int)L; { const int q = nwg / NXCD, r = nwg % NXCD, xcd = wgid % NXCD, off = wgid / NXCD; wgid = (xcd < r ? xcd * (q + 1) : r * (q + 1) + (xcd - r) * q) + off; }
        const int nig = WGM * nN, gid = wgid / nig, fm = gid * WGM, gsz = (nM - fm) < WGM ? (nM - fm) : WGM;
        u.pm = fm + ((wgid % nig) % gsz); u.pn = (wgid % nig) / gsz; return true;
    }
};
struct EpiCtx { int wr, wc, fr, fq, wid, lane; LAS unsigned char* xl; };

template <class Epi>
__device__ __forceinline__ void gemm_phase(LAS unsigned char* lds, const Gemm g, const StaticOrder& S, const Epi& E) {
    int tid_ = threadIdx.x; asm volatile("" : "+v"(tid_));
    const int tid = tid_, wid = __builtin_amdgcn_readfirstlane(tid >> 6), lane = tid & 63, wr = wid >> 2, wc = wid & 3, fr = lane & 15, fq = lane >> 4;
    const int K = g.K, nt = K / BK;
    unsigned voffA[2], voffB[2];
#pragma unroll
    for (int i = 0; i < 2; ++i) { int R, C; stage_rc(tid * 16 + i * 8192, R, C); const int Rb = Epi::PERM ? ((R & ~31) + perm32(R & 31)) : R;
        voffA[i] = (unsigned)(R * g.lda + C) * 2u; voffB[i] = (unsigned)(Rb * g.ldb + C) * 2u; }
    const size_t kstep = (size_t)(BK * 2);
    const size_t hstepA = (size_t)HALF * g.lda * 2, hstepB = (size_t)HALF * g.ldb * 2;
    const unsigned ldsw = (unsigned)wid * 1024u;
    const int aoff = lds_byte(wr * 64 + fr, fq * 8), boff = lds_byte(wc * 32 + fr, fq * 8);
    EpiCtx cx; cx.wr = wr; cx.wc = wc; cx.fr = fr; cx.fq = fq; cx.wid = wid; cx.lane = lane; cx.xl = lds + XLDS_OFF;
#define PG8_SA(b, h) (((b) * 2 + (h)) * HTB)
#define PG8_SB(b, h) ((4 + (b) * 2 + (h)) * HTB)
#define PG8_STAGE(bufoff, gbase, voff) do { _Pragma("unroll") for (int _i = 0; _i < 2; ++_i) \
        __builtin_amdgcn_global_load_lds((const unsigned*)((const char*)(gbase) + (voff)[_i]), (LAS unsigned*)(lds + (bufoff) + ldsw + _i * 8192), 16, 0, 0); } while (0)
#define PG8_LDA(dst, b, h) do { _Pragma("unroll") for (int m = 0; m < 4; ++m) _Pragma("unroll") for (int k = 0; k < 2; ++k) dst[m][k] = *(const LAS bf16x8*)(lds + PG8_SA(b, h) + aoff + m * 2048 + k * 1024); } while (0)
#define PG8_LDB(dst, b, h) do { _Pragma("unroll") for (int n = 0; n < 2; ++n) _Pragma("unroll") for (int k = 0; k < 2; ++k) dst[n][k] = *(const LAS bf16x8*)(lds + PG8_SB(b, h) + boff + n * 2048 + k * 1024); } while (0)
#define PG8_MMA(ai, bj, At, Bt) do { __builtin_amdgcn_s_setprio(1); _Pragma("unroll") for (int m = 0; m < 4; ++m) _Pragma("unroll") for (int n = 0; n < 2; ++n) _Pragma("unroll") for (int k = 0; k < 2; ++k) \
        acc[ai][bj][m][n] = __builtin_amdgcn_mfma_f32_16x16x32_bf16(Bt[n][k], At[m][k], acc[ai][bj][m][n], 0, 0, 0); __builtin_amdgcn_s_setprio(0); } while (0)
#define PG8_WAIT_V(n) asm volatile("s_waitcnt vmcnt(" #n ")" ::: "memory")
#define PG8_WAIT_L(n) asm volatile("s_waitcnt lgkmcnt(" #n ")" ::: "memory")
#define PG8_BAR __builtin_amdgcn_s_barrier()
#define PG8_SCHED __builtin_amdgcn_sched_barrier(0)
    Unit cur, nxt; int ui = 0;
    if (!S.next(0, cur)) return;
    f32x4 acc[2][2][4][2];
#pragma unroll
    for (int a = 0; a < 2; ++a)
#pragma unroll
        for (int b = 0; b < 2; ++b)
#pragma unroll
            for (int m = 0; m < 4; ++m)
#pragma unroll
                for (int n = 0; n < 2; ++n) acc[a][b][m][n] = (f32x4){0.f, 0.f, 0.f, 0.f};
    bf16x8 At[4][2], B0[2][2], B1[2][2];
    const char* cA = (const char*)g.A + (size_t)cur.pm * g.a_pm + (size_t)cur.pn * g.a_pn;
    const char* cB = (const char*)g.Bt + (size_t)cur.pn * g.b_pn + (size_t)(cur.pm >> g.b_sh) * g.b_pm;
    PG8_STAGE(PG8_SB(0, 0), cB, voffB); PG8_STAGE(PG8_SB(0, 1), cB + hstepB, voffB); PG8_STAGE(PG8_SA(0, 0), cA, voffA); PG8_STAGE(PG8_SA(0, 1), cA + hstepA, voffA);
    if (wr == 1) PG8_BAR;
    PG8_WAIT_V(2); PG8_BAR;
    PG8_STAGE(PG8_SB(1, 0), cB + kstep, voffB); PG8_STAGE(PG8_SA(1, 0), cA + kstep, voffA); PG8_STAGE(PG8_SB(1, 1), cB + hstepB + kstep, voffB);
    PG8_WAIT_V(6); PG8_BAR;
    for (;;) {
        if constexpr (Epi::RSPRE) {
            if (wid < 4) __builtin_amdgcn_global_load_lds((const unsigned*)((const char*)E.rs_src() + (size_t)cur.pm * 4096 + (unsigned)(tid << 4)), (LAS unsigned*)(lds + XLDS_OFF + 12288 + wid * 1024), 16, 0, 0); }
        const bool has_next = S.next(ui + 1, nxt);
        const char* nA = has_next ? (const char*)g.A + (size_t)nxt.pm * g.a_pm + (size_t)nxt.pn * g.a_pn : cA;
        const char* nB = has_next ? (const char*)g.Bt + (size_t)nxt.pn * g.b_pn + (size_t)(nxt.pm >> g.b_sh) * g.b_pm : cB;
        for (int t = 0; t < nt; t += 2) {
            const bool last = (t == nt - 2);
            const char* a1 = cA + (size_t)(t + 1) * kstep;
            const char* a2 = last ? nA : cA + (size_t)(t + 2) * kstep; const char* b2 = last ? nB : cB + (size_t)(t + 2) * kstep;
            const char* a3 = a2 + kstep; const char* b3 = b2 + kstep;
            PG8_LDB(B0, 0, 0); PG8_LDB(B1, 0, 1); PG8_SCHED; PG8_LDA(At, 0, 0); PG8_STAGE(PG8_SA(1, 1), a1 + hstepA, voffA);
            PG8_WAIT_V(8); PG8_WAIT_L(0); PG8_BAR; PG8_MMA(0, 0, At, B0); PG8_MMA(0, 1, At, B1); PG8_BAR; PG8_SCHED;
            PG8_LDA(At, 0, 1); PG8_STAGE(PG8_SB(0, 0), b2, voffB); PG8_STAGE(PG8_SB(0, 1), b2 + hstepB, voffB); PG8_STAGE(PG8_SA(0, 0), a2, voffA);
            PG8_WAIT_V(8); PG8_WAIT_L(0); PG8_BAR; PG8_MMA(1, 0, At, B0); PG8_MMA(1, 1, At, B1); PG8_BAR; PG8_SCHED;
            PG8_LDB(B0, 1, 0); PG8_LDB(B1, 1, 1); PG8_SCHED; PG8_LDA(At, 1, 0); PG8_STAGE(PG8_SA(0, 1), a2 + hstepA, voffA);
            PG8_WAIT_V(8); PG8_WAIT_L(0); PG8_BAR; PG8_MMA(0, 0, At, B0); PG8_MMA(0, 1, At, B1); PG8_BAR; PG8_SCHED;
            PG8_LDA(At, 1, 1); PG8_STAGE(PG8_SB(1, 0), b3, voffB); PG8_STAGE(PG8_SB(1, 1), b3 + hstepB, voffB); PG8_STAGE(PG8_SA(1, 0), a3, voffA);
            PG8_WAIT_V(8); PG8_WAIT_L(0); PG8_BAR; PG8_MMA(1, 0, At, B0); PG8_MMA(1, 1, At, B1); PG8_BAR; PG8_SCHED;
        }
        if (wr == 0) PG8_BAR;
        { EpiCtx cy = cx; asm volatile("" : "+v"(cy.fr), "+v"(cy.fq), "+v"(cy.lane));
          E(acc, cur, cy); }
        if (!has_next) break;
#pragma unroll
        for (int a = 0; a < 2; ++a)
#pragma unroll
            for (int b = 0; b < 2; ++b)
#pragma unroll
                for (int m = 0; m < 4; ++m)
#pragma unroll
                    for (int n = 0; n < 2; ++n) acc[a][b][m][n] = (f32x4){0.f, 0.f, 0.f, 0.f};
        cur = nxt; cA = nA; cB = nB; ++ui;
        if (wr == 1) PG8_BAR;
    }
    PG8_WAIT_V(0);
    PG8_BAR;
#undef PG8_SA
#undef PG8_SB
#undef PG8_STAGE
#undef PG8_LDA
#undef PG8_LDB
#undef PG8_MMA
#undef PG8_WAIT_V
#undef PG8_WAIT_L
#undef PG8_BAR
#undef PG8_SCHED
}
}
using pg8::Unit; using pg8::EpiCtx;
typedef f32x4 (&AccRef)[2][2][4][2];

__device__ __forceinline__ void load_rs(const float* rsp, const Unit& u, const EpiCtx& cx, float inv_n, float eps, float (&rs)[2][4]) {
#pragma unroll
    for (int ai = 0; ai < 2; ++ai)
#pragma unroll
        for (int m = 0; m < 4; ++m) { const int row = u.pm * 256 + ai * 128 + cx.wr * 64 + m * 16 + cx.fr; const f32x4 p = *(const f32x4*)(rsp + (size_t)row * 4);
            rs[ai][m] = fast_rsq(((p[0] + p[1]) + (p[2] + p[3])) * inv_n + eps); }
}
__device__ __forceinline__ void load_rs_lds(const EpiCtx& cx, float inv_n, float eps, float (&rs)[2][4]) {
#pragma unroll
    for (int ai = 0; ai < 2; ++ai)
#pragma unroll
        for (int m = 0; m < 4; ++m) { const int rl = ai * 128 + cx.wr * 64 + m * 16 + cx.fr; const f32x4 p = *(const LAS f32x4*)(cx.xl + 12288 + rl * 16);
            rs[ai][m] = fast_rsq(((p[0] + p[1]) + (p[2] + p[3])) * inv_n + eps); }
}
__device__ __forceinline__ void row_swap16(float v, float& a, float& b) { const unsigned u = __builtin_bit_cast(unsigned, v); const auto r = __builtin_amdgcn_permlane16_swap(u, u, false, false);
    const unsigned r0 = r[0], r1 = r[1]; a = __builtin_bit_cast(float, r0); b = __builtin_bit_cast(float, r1); }
__device__ __forceinline__ void row_swap32(float v, float& a, float& b) { const unsigned u = __builtin_bit_cast(unsigned, v); const auto r = __builtin_amdgcn_permlane32_swap(u, u, false, false);
    const unsigned r0 = r[0], r1 = r[1]; a = __builtin_bit_cast(float, r0); b = __builtin_bit_cast(float, r1); }
__device__ __forceinline__ float red_fq(float v) { float a, b; row_swap16(v, a, b); v = a + b; row_swap32(v, a, b); return a + b; }
__device__ __forceinline__ float max_fq(float v) { float a, b; row_swap16(v, a, b); v = fmaxf(a, b); row_swap32(v, a, b); return fmaxf(a, b); }

enum InIdx { I_X = 0, I_MEM, I_HLB, I_EMN, I_EWIN, I_EAON, I_EBCONV, I_EWOUT, I_OMN, I_OWIN, I_OCQN, I_OCKVN, I_OWUQ, I_OWUK, I_OWUV, I_OIDXWQ, I_OIDXKG, I_OIDXKB,
             I_ODVG, I_ODVB, I_ODWS, I_ODBS, I_OWOUT, I_XAN, I_XAMN, I_XAWQ, I_XAWKV, I_XAWO, I_FFN, I_FFW13, I_FFW2, I_FINAL, N_IN };
struct Args { const float* in[32]; float* out; unsigned char* ws; int ph_lo, ph_hi, fin_slot, pad; };
struct Frame { LAS unsigned char* lds; int tid, lane, wave, G, gw, NGW; };
#define INP(i) (*(const float* const LAS*)(F.lds + PTAB_OFF + 8 * (i)))

__device__ __forceinline__ void tr_item(const float* W, int ldw, int k0, int s0, int nvalid, bf16_t* WT, int ldwt, int n0, int kout0, const float* gain, float scale, LAS float* scr, int lane) {
    const int j = lane & 31;
#pragma unroll 8
    for (int i = 0; i < 32; ++i) { const int kk = 2 * i + (lane >> 5); float v = (j < nvalid) ? W[(size_t)(k0 + kk) * ldw + s0 + j] : 0.f; if (gain) v *= gain[k0 + kk]; scr[kk * 33 + j] = v * scale; }
    LDS_WAIT(); asm volatile("" ::: "memory");
    const int c = lane & 7;
#pragma unroll
    for (int jj = 0; jj < 4; ++jj) { const int n = (lane >> 3) + 8 * jj; const LAS float* s = scr + (8 * c) * 33 + n;
        u32x4 o; o.x = cvt_pk_bf16(s[0 * 33], s[1 * 33]); o.y = cvt_pk_bf16(s[2 * 33], s[3 * 33]); o.z = cvt_pk_bf16(s[4 * 33], s[5 * 33]); o.w = cvt_pk_bf16(s[6 * 33], s[7 * 33]);
        *(u32x4*)(WT + (size_t)(n0 + n) * ldwt + kout0 + k0 + 8 * c) = o; }
    LDS_WAIT(); asm volatile("" ::: "memory");
}
__device__ __forceinline__ int in0_src_col(int n) { const int pn = n >> 8, j = n & 255;
    if (pn < 4) return j < 128 ? pn * 128 + j : 512 + pn * 128 + (j - 128);
    if (pn < 10) return 1024 + (pn - 4) * 256 + j;
    const int q = pn - 10; return j < 128 ? 2560 + q * 128 + j : 3072 + q * 128 + (j - 128); }

__device__ __forceinline__ void p0_prologue(const Frame& F, unsigned char* ws) {
    LAS float* scr = (LAS float*)(F.lds + F.wave * 16384);
    constexpr int NJ = 17;
    const int jitems[NJ] = {1792, 512, 768, 64, 256, 0, 0, 512, 512, 512, 512, 512, 512, 2816, 2816, 1408, 1408};
    int total = 0;
#pragma unroll
    for (int j = 0; j < NJ; ++j) total += jitems[j];
    for (int it = F.gw; it < total; it += F.NGW) {
        int r = it, job = 0;
#pragma unroll
        for (int j = 0; j < NJ - 1; ++j) { if (job == j && r >= jitems[j]) { r -= jitems[j]; job = j + 1; } }
        const float* W; int ldw, K, Nout, ldwt, kout0 = 0; bf16_t* WT; const float* gain = nullptr; float scale = 1.f;
        switch (job) {
        case 0: W = INP(I_EWIN); ldw = NIN0; K = 1024; Nout = NIN0; WT = (bf16_t*)(ws + WS_W_IN0T); ldwt = 1024; gain = INP(I_EMN); break;
        case 1: W = INP(I_EWOUT); ldw = 1024; K = 1024; Nout = 1024; WT = (bf16_t*)(ws + WS_W_OUT0T); ldwt = 1024; break;
        case 2: W = INP(I_OWIN); ldw = 1480; K = 1024; Nout = 1536; WT = (bf16_t*)(ws + WS_W_IN1T); ldwt = 1024; gain = INP(I_OMN); break;
        case 3: W = INP(I_OIDXWQ); ldw = 512; K = 256; Nout = 512; WT = (bf16_t*)(ws + WS_W_Q1T) + (size_t)1024 * 256; ldwt = 256; gain = INP(I_OCQN); scale = 0.125f; break;
        case 4: W = INP(I_OWOUT) + (size_t)512 * 1024; ldw = 1024; K = 512; Nout = 1024; WT = (bf16_t*)(ws + WS_W_OUT1T); ldwt = 1536; kout0 = 1024; break;
        case 5: case 6: { const int L = job - 5; W = INP(I_XAWQ) + (size_t)L * D * D; ldw = 1024; K = 1024; Nout = 1024; WT = (bf16_t*)(ws + WS_W_XQT) + (size_t)L * D * D; ldwt = 1024; gain = INP(I_XAN) + L * D; } break;
        case 7: case 8: { const int L = job - 7; W = INP(I_XAWKV) + (size_t)L * D * 2048; ldw = 2048; K = 1024; Nout = 1024; WT = (bf16_t*)(ws + WS_W_XKT) + (size_t)L * D * D; ldwt = 1024; gain = INP(I_XAMN) + L * D; } break;
        case 9: case 10: { const int L = job - 9; W = INP(I_XAWKV) + (size_t)L * D * 2048 + 1024; ldw = 2048; K = 1024; Nout = 1024; WT = (bf16_t*)(ws + WS_W_XVT) + (size_t)L * D * D; ldwt = 1024; gain = INP(I_XAMN) + L * D; } break;
        case 11: case 12: { const int L = job - 11; W = INP(I_XAWO) + (size_t)L * D * D; ldw = 1024; K = 1024; Nout = 1024; WT = (bf16_t*)(ws + WS_W_XOT) + (size_t)L * D * D; ldwt = 1024; } break;
        case 13: case 14: { const int L = job - 13; W = INP(I_FFW13) + (size_t)L * D * 5632; ldw = 5632; K = 1024; Nout = 5632; WT = (bf16_t*)(ws + WS_W_13T) + (size_t)L * 5632 * D; ldwt = 1024; gain = INP(I_FFN) + L * D; } break;
        default: { const int L = job - 15; W = INP(I_FFW2) + (size_t)L * FF * D; ldw = 1024; K = FF; Nout = 1024; WT = (bf16_t*)(ws + WS_W_2T) + (size_t)L * D * FF; ldwt = FF; } break;
        }
        const int nblk = Nout / 32, kb = r / nblk, nb = r % nblk, n0 = nb * 32; int s0 = n0, nvalid = 32;
        if (job == 0) s0 = in0_src_col(n0);
        else if (job == 2) { if (n0 < 448) s0 = n0; else if (n0 == 448) { s0 = 448; nvalid = 8; } else if (n0 < 512) { s0 = 0; nvalid = 0; } else s0 = n0 - 56; }
        else if (job == 13 || job == 14) { const int pn = n0 >> 8, j = n0 & 255; s0 = j < 128 ? pn * 128 + j : 2816 + pn * 128 + (j - 128); }
        tr_item(W, ldw, kb * 64, s0, nvalid, WT, ldwt, n0, kout0, gain, scale, scr, F.lane);
    }
    const int gt = F.gw * 64 + F.lane, NGT = F.NGW * 64;
    { const float* wuq = INP(I_OWUQ); const float* wuk = INP(I_OWUK); const float* g = INP(I_OCQN); bf16_t* WT = (bf16_t*)(ws + WS_W_Q1T);
      for (int o = gt; o < 1024 * 256; o += NGT) { const int n = o & 1023, r = o >> 10, h = n >> 7, c = n & 127; float s = 0.f;
          for (int d = 0; d < 64; ++d) s += wuq[(size_t)r * 512 + h * 64 + d] * wuk[(size_t)(h * 64 + d) * 128 + c];
          WT[(size_t)n * 256 + r] = (bf16_t)(cvt_pk_bf16(s * 0.125f * g[r], 0.f) & 0xffffu); } }
    { const float* wuv = INP(I_OWUV); const float* wo = INP(I_OWOUT); bf16_t* WT = (bf16_t*)(ws + WS_W_OUT1T);
      for (int o = gt; o < 1024 * 1024; o += NGT) { const int n = o & 1023, k = o >> 10, h = k >> 7; float s = 0.f;
          for (int d = 0; d < 64; ++d) s += wuv[(size_t)k * 64 + d] * wo[(size_t)(h * 64 + d) * 1024 + n];
          WT[(size_t)n * 1536 + k] = (bf16_t)(cvt_pk_bf16(s, 0.f) & 0xffffu); } }
    { const float* wq = INP(I_XAWQ); const float* g = INP(I_XAN); bf16_t* WN = (bf16_t*)(ws + WS_W_XQT);
      for (int o = gt; o < 2 * D * D / 4; o += NGT) { const f32x4 v = *((const f32x4*)wq + o); const float gg = g[(o * 4) >> 10]; *((u32x2*)WN + o) = pack4(v * gg); } }
    { const float* wsrc = INP(I_ODWS); bf16_t* WC = (bf16_t*)(ws + WS_WC);
      for (int o = gt; o < 4 * 128 * 128; o += NGT) { const int s = o & 127, t = (o >> 7) & 127; WC[o] = (bf16_t)(cvt_pk_bf16(s <= t ? wsrc[o] : 0.f, 0.f) & 0xffffu); }
      const float* hl = INP(I_HLB); float* lb = (float*)(ws + WS_LB);
      for (int o = gt; o < 512; o += NGT) { const float x0 = hl[o], x1 = hl[512 + o], x2 = hl[1024 + o], mx = fmaxf(x0, fmaxf(x1, x2));
          const float e0 = __expf(x0 - mx), e1 = __expf(x1 - mx), e2 = __expf(x2 - mx); lb[o] = e0 / (e0 + e1 + e2); } }
    { const float* x = INP(I_X); bf16_t* XB = (bf16_t*)(ws + WS_XB); float* rsp = (float*)(ws + WS_RSP);
      for (int m = F.gw; m < M + MROWS; m += F.NGW) {
          const bool is_mem = m >= M; const int row = is_mem ? m - M : m;
          const float* src = is_mem ? INP(I_MEM) + (size_t)row * D : x + (size_t)row * D; bf16_t* dst = is_mem ? (bf16_t*)(ws + WS_MEMB) + (size_t)row * D : XB + (size_t)row * D;
          const f32x4* xr = (const f32x4*)src + F.lane; f32x4 v[4]; float s = 0.f;
#pragma unroll
          for (int j = 0; j < 4; ++j) { v[j] = xr[64 * j]; s += (v[j].x * v[j].x + v[j].y * v[j].y) + (v[j].z * v[j].z + v[j].w * v[j].w); }
          s = wave_sum(s);
          u32x2* o8 = (u32x2*)dst + F.lane;
#pragma unroll
          for (int j = 0; j < 4; ++j) { u32x2 w; w.x = cvt_pk_bf16(v[j].x, v[j].y); w.y = cvt_pk_bf16(v[j].z, v[j].w); o8[64 * j] = w; }
          if (F.lane == 0) { if (is_mem) ((float*)(ws + WS_MEMRS))[row] = fast_rsq(s * (1.0f / D) + 1e-6f); else *(f32x4*)(rsp + (size_t)row * 4) = (f32x4){s, 0.f, 0.f, 0.f}; }
      } }
}


struct EpiRes { static constexpr bool PERM = true; static constexpr bool RSPRE = false;
    bf16_t* xb; float* rsp_out;
    __device__ __forceinline__ void operator()(AccRef acc, const Unit& u, const EpiCtx& cx) const {
        LAS float* T = (LAS float*)cx.xl;
        const int col0 = u.pn * 256 + cx.wc * 32 + 8 * cx.fq;
#pragma unroll
        for (int ai = 0; ai < 2; ++ai) {
            u32x4 xo[4][2];
#pragma unroll
            for (int m = 0; m < 4; ++m)
#pragma unroll
                for (int bj = 0; bj < 2; ++bj) xo[m][bj] = *(const u32x4*)(xb + (size_t)(u.pm * 256 + ai * 128 + cx.wr * 64 + m * 16 + cx.fr) * D + col0 + bj * 128);
#pragma unroll
            for (int m = 0; m < 4; ++m) { const int rl = ai * 128 + cx.wr * 64 + m * 16 + cx.fr; const size_t off = (size_t)(u.pm * 256 + rl) * D + col0; float ss = 0.f;
#pragma unroll
                for (int bj = 0; bj < 2; ++bj) { const u32x4 xv = xo[m][bj];
                    const f32x4 v0 = (f32x4){bflo(xv.x), bfhi(xv.x), bflo(xv.y), bfhi(xv.y)} + acc[ai][bj][m][0], v1 = (f32x4){bflo(xv.z), bfhi(xv.z), bflo(xv.w), bfhi(xv.w)} + acc[ai][bj][m][1];
                    *(u32x4*)(xb + off + bj * 128) = pack8(v0, v1);
                    ss += ((v0[0] * v0[0] + v0[1] * v0[1]) + (v0[2] * v0[2] + v0[3] * v0[3])) + ((v1[0] * v1[0] + v1[1] * v1[1]) + (v1[2] * v1[2] + v1[3] * v1[3])); }
                ss = red_fq(ss); if (cx.fq == 0) T[rl * 4 + cx.wc] = ss; }
            asm volatile("" ::: "memory"); }
        LDS_BAR();
        const int tid = cx.wid * 64 + cx.lane;
        if (tid < 256) { const f32x4 t = *(const LAS f32x4*)(T + tid * 4); rsp_out[(size_t)(u.pm * 256 + tid) * 4 + u.pn] = (t[0] + t[1]) + (t[2] + t[3]); }
    }
};
struct EpiBf { static constexpr bool PERM = true; static constexpr bool RSPRE = false;
    bf16_t* O; int ldc; const float* rsv; int rs_mode; int split_pn; bf16_t* O2; int ldc2; int pn_stride;
    __device__ __forceinline__ void operator()(AccRef acc, const Unit& u, const EpiCtx& cx) const {
        bf16_t* base = O; int ld = ldc, pn = u.pn; if (pn >= split_pn) { base = O2; ld = ldc2; pn -= split_pn; }
        const size_t col0 = (size_t)pn * pn_stride + cx.wc * 32 + 8 * cx.fq;
        float rsa[2][4];
        if (rs_mode == 1) load_rs(rsv, u, cx, 1.0f / 1024.f, 1e-6f, rsa);
        else {
#pragma unroll
            for (int ai = 0; ai < 2; ++ai)
#pragma unroll
                for (int m = 0; m < 4; ++m) rsa[ai][m] = rs_mode == 2 ? rsv[u.pm * 256 + ai * 128 + cx.wr * 64 + m * 16 + cx.fr] : 1.f; }
#pragma unroll
        for (int ai = 0; ai < 2; ++ai)
#pragma unroll
            for (int m = 0; m < 4; ++m) { const int row = u.pm * 256 + ai * 128 + cx.wr * 64 + m * 16 + cx.fr; const float rs = rsa[ai][m];
                bf16_t* rowp = base + (size_t)row * ld + col0;
#pragma unroll
                for (int bj = 0; bj < 2; ++bj) *(u32x4*)(rowp + bj * 128) = pack8(acc[ai][bj][m][0] * rs, acc[ai][bj][m][1] * rs); }
    }
};
struct EpiS { static constexpr bool PERM = true; static constexpr bool RSPRE = true;
    __device__ __forceinline__ const float* rs_src() const { return rsp; }
    bf16_t* P; const float* rsp;
    __device__ __forceinline__ void operator()(AccRef acc, const Unit& u, const EpiCtx& cx) const {
        LAS float* MX = (LAS float*)cx.xl; LAS float* SM = MX + 1024;
        const float sc = 0.0625f * 1.4426950408889634f;
        { float rs[2][4]; load_rs_lds(cx, 1.0f / 1024.f, 1e-6f, rs);
#pragma unroll
          for (int ai = 0; ai < 2; ++ai)
#pragma unroll
              for (int m = 0; m < 4; ++m)
#pragma unroll
                  for (int bj = 0; bj < 2; ++bj)
#pragma unroll
                      for (int n = 0; n < 2; ++n) acc[ai][bj][m][n] = acc[ai][bj][m][n] * rs[ai][m]; }
#pragma unroll
        for (int ai = 0; ai < 2; ++ai)
#pragma unroll
            for (int m = 0; m < 4; ++m) { const int rl = ai * 128 + cx.wr * 64 + m * 16 + cx.fr; float mx = -3.0e38f;
#pragma unroll
                for (int bj = 0; bj < 2; ++bj)
#pragma unroll
                    for (int n = 0; n < 2; ++n) { const f32x4 v = acc[ai][bj][m][n]; mx = fmaxf(mx, fmaxf(fmaxf(v[0], v[1]), fmaxf(v[2], v[3]))); }
                mx = max_fq(mx); if (cx.fq == 0) MX[rl * 4 + cx.wc] = mx; }
        LDS_BAR();
#pragma unroll
        for (int ai = 0; ai < 2; ++ai)
#pragma unroll
            for (int m = 0; m < 4; ++m) { const int rl = ai * 128 + cx.wr * 64 + m * 16 + cx.fr; const f32x4 t = *(const LAS f32x4*)(MX + rl * 4);
                const float mx = fmaxf(fmaxf(t[0], t[1]), fmaxf(t[2], t[3])) * sc; float s = 0.f;
#pragma unroll
                for (int bj = 0; bj < 2; ++bj)
#pragma unroll
                    for (int n = 0; n < 2; ++n) { f32x4 v = acc[ai][bj][m][n];
#pragma unroll
                        for (int i = 0; i < 4; ++i) { v[i] = fast_exp2(v[i] * sc - mx); s += v[i]; }
                        acc[ai][bj][m][n] = v; }
                s = red_fq(s); if (cx.fq == 0) SM[rl * 4 + cx.wc] = s; }
        LDS_BAR();
        const int col0 = u.pn * 256 + cx.wc * 32 + 8 * cx.fq;
#pragma unroll
        for (int ai = 0; ai < 2; ++ai)
#pragma unroll
            for (int m = 0; m < 4; ++m) { const int rl = ai * 128 + cx.wr * 64 + m * 16 + cx.fr; const f32x4 t = *(const LAS f32x4*)(SM + rl * 4);
                const float inv = fast_rcp((t[0] + t[1]) + (t[2] + t[3])); bf16_t* rowp = P + (size_t)(u.pm * 256 + rl) * D + col0;
#pragma unroll
                for (int bj = 0; bj < 2; ++bj) *(u32x4*)(rowp + bj * 128) = pack8(acc[ai][bj][m][0] * inv, acc[ai][bj][m][1] * inv); }
    }
};
struct EpiFfn1 { static constexpr bool PERM = true; static constexpr bool RSPRE = true;
    bf16_t* ACT; const float* rsp;
    __device__ __forceinline__ const float* rs_src() const { return rsp; }
    __device__ __forceinline__ void operator()(AccRef acc, const Unit& u, const EpiCtx& cx) const {
        const int col0 = u.pn * 128 + cx.wc * 32 + 8 * cx.fq;
        float rsa[2][4]; load_rs_lds(cx, 1.0f / 1024.f, 1e-6f, rsa);
        LDS_BAR();
#pragma unroll
        for (int ai = 0; ai < 2; ++ai)
#pragma unroll
            for (int m = 0; m < 4; ++m) { const int row = u.pm * 256 + ai * 128 + cx.wr * 64 + m * 16 + cx.fr;
                const float rs = rsa[ai][m]; f32x4 o[2];
#pragma unroll
                for (int n = 0; n < 2; ++n)
#pragma unroll
                    for (int i = 0; i < 4; ++i) o[n][i] = silu_f(acc[ai][0][m][n][i] * rs) * (acc[ai][1][m][n][i] * rs);
                *(u32x4*)(ACT + (size_t)row * FF + col0) = pack8(o[0], o[1]); }
    }
};
template <int CTRL> __device__ __forceinline__ float dppf(float v) { return __builtin_bit_cast(float, __builtin_amdgcn_update_dpp(0, __builtin_bit_cast(int, v), CTRL, 0xf, 0xf, true)); }
__device__ __forceinline__ float row_scan16(float v) { v += dppf<0x111>(v); v += dppf<0x112>(v); v += dppf<0x114>(v); v += dppf<0x118>(v); return v; }
__device__ __forceinline__ float row_last16(float v) { return dppf<0x15F>(v); }
__device__ __forceinline__ float row_sum16(float v) { v += dppf<0x128>(v); v += dppf<0x124>(v); v += dppf<0x122>(v); v += dppf<0x121>(v); return v; }

struct EpiIn0 { static constexpr bool PERM = true; static constexpr bool RSPRE = true;
    unsigned char* ws;
    __device__ __forceinline__ const float* rs_src() const { return (const float*)(ws + WS_RSP); }
    __device__ __forceinline__ void operator()(AccRef acc, const Unit& u, const EpiCtx& cx) const {
        const float* rsp = (const float*)(ws + WS_RSP); const float* lb = (const float*)(ws + WS_LB); bf16_t* QE = (bf16_t*)(ws + WS_QE); bf16_t* KINV = (bf16_t*)(ws + WS_KINV); bf16_t* HZ = (bf16_t*)(ws + WS_HZ); float* EBG = (float*)(ws + WS_EBG);
        float rs[2][4]; load_rs_lds(cx, 1.0f / 1024.f, 1e-6f, rs); (void)rsp;
        LDS_BAR();
        const int pn = u.pn;
        if (pn < 4) {
            const int ch0 = pn * 128 + cx.wc * 32 + 8 * cx.fq;
#pragma unroll
            for (int ai = 0; ai < 2; ++ai) {
                const int row0 = u.pm * 256 + ai * 128 + cx.wr * 64;
#pragma unroll
                for (int n = 0; n < 2; ++n) {
                    const f32x4 lbv = *(const f32x4*)(lb + ch0 + 4 * n);
                    f32x4 oq[4], oi[4], eb;
#pragma unroll
                    for (int i = 0; i < 4; ++i) {
                        float l2[4], kk[4], tot[4];
#pragma unroll
                        for (int m = 0; m < 4; ++m) { const float x = acc[ai][1][m][n][i] * rs[ai][m]; const float f = lbv[i] + (1.0f - lbv[i]) * sigmoid_f(x);
                            kk[m] = 1.0f - f; l2[m] = row_scan16(__builtin_amdgcn_logf(f)); tot[m] = row_last16(l2[m]); }
                        const float btot = (tot[0] + tot[1]) + (tot[2] + tot[3]); float pre = 0.f;
#pragma unroll
                        for (int m = 0; m < 4; ++m) { const float b = l2[m] + pre; pre += tot[m];
                            const float q = silu_f(acc[ai][0][m][n][i] * rs[ai][m]);
                            oq[m][i] = q * fast_exp2(b); oi[m][i] = kk[m] * fast_exp2(fminf(-b, 100.f)); }
                        eb[i] = fast_exp2(btot);
                    }
#pragma unroll
                    for (int m = 0; m < 4; ++m) { const size_t o = (size_t)(row0 + m * 16 + cx.fr) * 512 + ch0 + 4 * n;
                        *(u32x2*)(QE + o) = pack4(oq[m]); *(u32x2*)(KINV + o) = pack4(oi[m]); }
                    if (cx.fr == 0) *(f32x4*)(EBG + (size_t)(row0 >> 6) * 512 + ch0 + 4 * n) = eb;
                    __builtin_amdgcn_sched_barrier(0);
                }
            }
        } else if (pn < 10) {
            bf16_t* T = (bf16_t*)(ws + (pn < 6 ? WS_HV : (pn < 8 ? WS_HG : WS_HB))); const bool act = (pn == 6 || pn == 7);
            const int col0 = (pn & 1) * 256 + cx.wc * 32 + 8 * cx.fq;
#pragma unroll
            for (int ai = 0; ai < 2; ++ai)
#pragma unroll
                for (int m = 0; m < 4; ++m) { const int row = u.pm * 256 + ai * 128 + cx.wr * 64 + m * 16 + cx.fr; const float r = rs[ai][m];
#pragma unroll
                    for (int bj = 0; bj < 2; ++bj) { f32x4 a = acc[ai][bj][m][0] * r, b = acc[ai][bj][m][1] * r;
                        if (act) {
#pragma unroll
                            for (int i = 0; i < 4; ++i) { a[i] = silu_f(a[i]); b[i] = silu_f(b[i]); } }
                        *(u32x4*)(T + (size_t)row * 512 + col0 + bj * 128) = pack8(a, b); } }
        } else {
            const int col0 = (pn - 10) * 128 + cx.wc * 32 + 8 * cx.fq;
#pragma unroll
            for (int ai = 0; ai < 2; ++ai)
#pragma unroll
                for (int m = 0; m < 4; ++m) { const int row = u.pm * 256 + ai * 128 + cx.wr * 64 + m * 16 + cx.fr; const float r2 = rs[ai][m] * rs[ai][m];
                    *(u32x4*)(HZ + (size_t)row * 512 + col0) = pack8(acc[ai][0][m][0] * acc[ai][1][m][0] * r2, acc[ai][0][m][1] * acc[ai][1][m][1] * r2); }
        }
    }
};
__device__ __forceinline__ unsigned off_b(unsigned row, unsigned ch) { return 256u * row + 16u * (ch ^ (((row & 3) << 2) | ((row >> 2) & 3))); }
__device__ __forceinline__ s16x4 ldtr(const LAS unsigned char* p) { return __builtin_amdgcn_ds_read_tr16_b64_v4i16((LAS s16x4*)p); }
__device__ __forceinline__ bf16x8 mk8(s16x4 a, s16x4 b) { return (bf16x8){a[0], a[1], a[2], a[3], b[0], b[1], b[2], b[3]}; }
__device__ __forceinline__ s16x4 tr_blk(const LAS unsigned char* img, int r0, int c, int lane) { const int q = (lane & 15) >> 2, p = lane & 3; return ldtr(img + off_b(r0 + q, 2 * c + (p >> 1)) + 8 * (p & 1)); }
__device__ __forceinline__ void unpack8(u32x4 w, float (&f)[8]) { f[0] = bflo(w.x); f[1] = bfhi(w.x); f[2] = bflo(w.y); f[3] = bfhi(w.y); f[4] = bflo(w.z); f[5] = bfhi(w.z); f[6] = bflo(w.w); f[7] = bfhi(w.w); }
__device__ __forceinline__ u32x4 pack8f(const float (&f)[8]) { u32x4 w; w.x = cvt_pk_bf16(f[0], f[1]); w.y = cvt_pk_bf16(f[2], f[3]); w.z = cvt_pk_bf16(f[4], f[5]); w.w = cvt_pk_bf16(f[6], f[7]); return w; }
#define MFMA16(A, B, C) __builtin_amdgcn_mfma_f32_16x16x32_bf16((A), (B), (C), 0, 0, 0)

constexpr int HG_BUF = 66048, HG_ATT = 2 * HG_BUF, HG_ATT_ROW = 144;
constexpr int HG_NSEG = 8, HG_SEGC = (SEQ / 64) / HG_NSEG;
__device__ __forceinline__ void hgrn_unit(const Frame& F, unsigned char* ws, int unit) {
    const int b = unit >> 5, h = (unit >> 3) & 3, seg = unit & 7, c0 = seg * HG_SEGC;
    const int tid = F.tid, lane0 = F.lane, w = F.wave;
    const unsigned char* gsrc = ws + WS_BIG1; const float* EBG = (const float*)(ws + WS_EBG); bf16_t* HO = (bf16_t*)(ws + WS_HO);
    LAS unsigned char* L = F.lds; LAS unsigned char* ATT = L + HG_ATT;
    u32x4 st[8]; f32x4 steb = (f32x4){0.f, 0.f, 0.f, 0.f};
    const int srow = (tid & 511) >> 4, sch = tid & 15;
#define HG_LOAD(ci) do { const size_t tok0_ = (size_t)b * SEQ + (size_t)(ci) * 64; \
        _Pragma("unroll") for (int j = 0; j < 8; ++j) if ((j >> 1) != 2) st[j] = *(const u32x4*)(gsrc + (size_t)(j >> 1) * T64 + ((tok0_ + srow + 32 * (j & 1)) * 512 + h * 128 + sch * 8) * 2); \
        if (tid < 32) steb = *(const f32x4*)(EBG + (tok0_ >> 6) * 512 + h * 128 + 4 * tid); } while (0)
#define HG_STORE(bufi) do { LAS unsigned char* B_ = L + (bufi) * HG_BUF; \
        _Pragma("unroll") for (int j = 0; j < 8; ++j) if ((j >> 1) != 2) *(LAS u32x4*)(B_ + (j >> 1) * 16384 + off_b(srow + 32 * (j & 1), sch)) = st[j]; \
        if (tid < 32) *(LAS f32x4*)(B_ + 65536 + 16 * tid) = steb; } while (0)
    f32x4 S[8];
#pragma unroll
    for (int kt = 0; kt < 8; ++kt) S[kt] = (f32x4){0.f, 0.f, 0.f, 0.f};
    {
      const float* SLOC = (const float*)(ws + WS_SLOC); const float* DSEG = (const float*)(ws + WS_DSEG); const int g_ = lane0 >> 4, c_ = lane0 & 15;
      f32x4 cum[8];
#pragma unroll
      for (int kt = 0; kt < 8; ++kt) cum[kt] = (f32x4){1.f, 1.f, 1.f, 1.f};
      for (int j = seg - 1; j >= 0; --j) { const int uj = (unit & ~7) | j; const float* sl = SLOC + (size_t)uj * 16384 + 16 * w + c_; const float* dj = DSEG + (size_t)uj * 128;
#pragma unroll
          for (int kt = 0; kt < 8; ++kt) { const f32x4 d4 = *(const f32x4*)(dj + 16 * kt + 4 * g_);
#pragma unroll
              for (int i = 0; i < 4; ++i) S[kt][i] += cum[kt][i] * sl[(16 * kt + 4 * g_ + i) * 128];
              cum[kt] = cum[kt] * d4; } } }
    HG_LOAD(c0); HG_STORE(0); LDS_BAR();
    for (int cr = 0; cr < HG_SEGC; ++cr) { const int ci = c0 + cr;
        const LAS unsigned char* B = L + (cr & 1) * HG_BUF; const LAS unsigned char* bQE = B; const LAS unsigned char* bKI = B + 16384; const LAS unsigned char* bKD = B + 32768; const LAS unsigned char* bV = B + 49152;
        const size_t tok0 = (size_t)b * SEQ + (size_t)ci * 64;
        const int lane = opq(lane0), g = lane >> 4, c = lane & 15;
        if (cr + 1 < HG_SEGC) HG_LOAD(ci + 1);
#pragma unroll
        for (int e = 0; e < 2; ++e) { const int id = 2 * w + e, mt = id >> 2, ns = id & 3; f32x4 acc = (f32x4){0.f, 0.f, 0.f, 0.f};
            if (mt >= ns) {
#pragma unroll
                for (int ks = 0; ks < 4; ++ks) { const bf16x8 Bq = *(const LAS bf16x8*)(bQE + off_b(16 * mt + c, 4 * ks + g)); const bf16x8 Ak = *(const LAS bf16x8*)(bKI + off_b(16 * ns + c, 4 * ks + g)); acc = MFMA16(Ak, Bq, acc); }
            }
            f32x4 v;
#pragma unroll
            for (int i = 0; i < 4; ++i) { const bool keep = (mt > ns) || (mt == ns && 4 * g + i <= c); v[i] = keep ? acc[i] : 0.f; }
            *(LAS u32x2*)(ATT + (16 * mt + c) * HG_ATT_ROW + (16 * ns + 4 * g) * 2) = pack4(v); }
        LDS_BAR();
        bf16x8 Sb[4];
#pragma unroll
        for (int ks = 0; ks < 4; ++ks) { u32x4 p; p.x = cvt_pk_bf16(S[2 * ks][0], S[2 * ks][1]); p.y = cvt_pk_bf16(S[2 * ks][2], S[2 * ks][3]); p.z = cvt_pk_bf16(S[2 * ks + 1][0], S[2 * ks + 1][1]); p.w = cvt_pk_bf16(S[2 * ks + 1][2], S[2 * ks + 1][3]); Sb[ks] = __builtin_bit_cast(bf16x8, p); }
        bf16x8 Vf[2];
#pragma unroll
        for (int k2 = 0; k2 < 2; ++k2) {
#if HG_DBG & 8
            bf16x8 t;
#pragma unroll
            for (int j = 0; j < 8; ++j) { const int srow_ = 32 * k2 + 8 * g + j, vcol = 16 * w + c; t[j] = *(const LAS short*)(bV + off_b(srow_, vcol >> 3) + (vcol & 7) * 2); }
            Vf[k2] = t;
#else
            Vf[k2] = mk8(tr_blk(bV, 32 * k2 + 8 * g, w, lane), tr_blk(bV, 32 * k2 + 8 * g + 4, w, lane));
#endif
        }
        f32x4 ao[4];
#pragma unroll
        for (int mt = 0; mt < 4; ++mt) { ao[mt] = (f32x4){0.f, 0.f, 0.f, 0.f};
#pragma unroll
            for (int ks = 0; ks < 4; ++ks) { const s16x4 a0 = *(const LAS s16x4*)(bQE + off_b(16 * mt + c, 4 * ks + (g >> 1)) + 8 * (g & 1)); const s16x4 a1 = *(const LAS s16x4*)(bQE + off_b(16 * mt + c, 4 * ks + 2 + (g >> 1)) + 8 * (g & 1));
                if (!(HG_DBG & 1)) ao[mt] = MFMA16(mk8(a0, a1), Sb[ks], ao[mt]); }
#pragma unroll
            for (int k2 = 0; k2 < 2; ++k2) { const bf16x8 A = *(const LAS bf16x8*)(ATT + (16 * mt + c) * HG_ATT_ROW + (32 * k2 + 8 * g) * 2); if (!(HG_DBG & 2)) ao[mt] = MFMA16(A, Vf[k2], ao[mt]); } }
#pragma unroll
        for (int mt = 0; mt < 4; ++mt)
#pragma unroll
            for (int i = 0; i < 4; ++i) HO[(tok0 + 16 * mt + 4 * g + i) * 512 + h * 128 + 16 * w + c] = (bf16_t)(cvt_pk_bf16(ao[mt][i], 0.f) & 0xffffu);
#pragma unroll
        for (int kt = 0; kt < 8; ++kt) { const f32x4 e4 = *(const LAS f32x4*)(B + 65536 + (16 * kt + 4 * g) * 4); f32x4 X = (f32x4){0.f, 0.f, 0.f, 0.f};
#pragma unroll
            for (int k2 = 0; k2 < 2; ++k2) { const bf16x8 A = mk8(tr_blk(bKI, 32 * k2 + 8 * g, kt, lane), tr_blk(bKI, 32 * k2 + 8 * g + 4, kt, lane)); X = MFMA16(A, Vf[k2], X); }
            S[kt] = S[kt] * e4 + X * e4; }
        if (cr + 1 < HG_SEGC) HG_STORE((cr + 1) & 1);
        LDS_BAR();
    }
#undef HG_LOAD
#undef HG_STORE
    WG_BAR();
    { const bf16_t* HG = (const bf16_t*)(ws + WS_HG); bf16_t* A0 = (bf16_t*)(ws + WS_A0); const int tl = lane0 >> 4, j = lane0 & 15; float gn[8];
#pragma unroll
      for (int i = 0; i < 8; ++i) gn[i] = INP(I_EAON)[h * 128 + 8 * j + i];
      const size_t tokf = (size_t)b * SEQ + (size_t)c0 * 64 + w * 128 + tl;
      u32x4 no_ = *(const u32x4*)(HO + tokf * 512 + h * 128 + 8 * j), ng_ = *(const u32x4*)(HG + tokf * 512 + h * 128 + 8 * j);
      for (int it = 0; it < 32; ++it) { const size_t tok = tokf + it * 4; const u32x4 co_ = no_, cg_ = ng_;
          if (it + 1 < 32) { const size_t offn = (tok + 4) * 512 + h * 128 + 8 * j; no_ = *(const u32x4*)(HO + offn); ng_ = *(const u32x4*)(HG + offn); }
          float o[8], gt[8], r[8]; unpack8(co_, o); unpack8(cg_, gt);
          float ss = 0.f;
#pragma unroll
          for (int i = 0; i < 8; ++i) ss += o[i] * o[i];
          ss = row_sum16(ss);
          const float rr = fast_rsq(ss * (1.0f / 128.f) + 1e-6f);
#pragma unroll
          for (int i = 0; i < 8; ++i) r[i] = o[i] * rr * gn[i] * gt[i];
          *(u32x4*)(A0 + tok * 1024 + h * 128 + 8 * j) = pack8f(r); } }
}
__device__ __forceinline__ void hgrn_passA(const Frame& F, unsigned char* ws, int unit) {
    const int b = unit >> 5, h = (unit >> 3) & 3, seg = unit & 7, c0 = seg * HG_SEGC;
    const int tid = F.tid, lane0 = F.lane, w = F.wave;
    const unsigned char* gsrc = ws + WS_BIG1; const float* EBG = (const float*)(ws + WS_EBG);
    LAS unsigned char* L = F.lds;
    constexpr int PA_BUF = 33280;
    u32x4 st[4]; f32x4 steb = (f32x4){0.f, 0.f, 0.f, 0.f};
    const int srow = (tid & 511) >> 4, sch = tid & 15;
#define PA_LOAD(ci) do { const size_t tok0_ = (size_t)b * SEQ + (size_t)(ci) * 64; \
        _Pragma("unroll") for (int j = 0; j < 4; ++j) st[j] = *(const u32x4*)(gsrc + (size_t)((j >> 1) ? 3 : 1) * T64 + ((tok0_ + srow + 32 * (j & 1)) * 512 + h * 128 + sch * 8) * 2); \
        if (tid < 32) steb = *(const f32x4*)(EBG + (tok0_ >> 6) * 512 + h * 128 + 4 * tid); } while (0)
#define PA_STORE(bufi) do { LAS unsigned char* B_ = L + (bufi) * PA_BUF; \
        _Pragma("unroll") for (int j = 0; j < 4; ++j) *(LAS u32x4*)(B_ + (j >> 1) * 16384 + off_b(srow + 32 * (j & 1), sch)) = st[j]; \
        if (tid < 32) *(LAS f32x4*)(B_ + 32768 + 16 * tid) = steb; } while (0)
    f32x4 S[8], dc[8];
#pragma unroll
    for (int kt = 0; kt < 8; ++kt) { S[kt] = (f32x4){0.f, 0.f, 0.f, 0.f}; dc[kt] = (f32x4){1.f, 1.f, 1.f, 1.f}; }
    PA_LOAD(c0); PA_STORE(0); LDS_BAR();
    for (int cr = 0; cr < HG_SEGC; ++cr) {
        const LAS unsigned char* B = L + (cr & 1) * PA_BUF; const LAS unsigned char* bKD = B; const LAS unsigned char* bV = B + 16384;
        const int lane = opq(lane0), g = lane >> 4;
        if (cr + 1 < HG_SEGC) PA_LOAD(c0 + cr + 1);
        bf16x8 Vf[2];
#pragma unroll
        for (int k2 = 0; k2 < 2; ++k2) Vf[k2] = mk8(tr_blk(bV, 32 * k2 + 8 * g, w, lane), tr_blk(bV, 32 * k2 + 8 * g + 4, w, lane));
#pragma unroll
        for (int kt = 0; kt < 8; ++kt) { const f32x4 e4 = *(const LAS f32x4*)(B + 32768 + (16 * kt + 4 * g) * 4); dc[kt] = dc[kt] * e4; f32x4 X = (f32x4){0.f, 0.f, 0.f, 0.f};
#pragma unroll
            for (int k2 = 0; k2 < 2; ++k2) { const bf16x8 A = mk8(tr_blk(bKD, 32 * k2 + 8 * g, kt, lane), tr_blk(bKD, 32 * k2 + 8 * g + 4, kt, lane)); X = MFMA16(A, Vf[k2], X); }
            S[kt] = S[kt] * e4 + X * e4; }
        if (cr + 1 < HG_SEGC) PA_STORE((cr + 1) & 1);
        LDS_BAR();
    }
    { float* sl = (float*)(ws + WS_SLOC) + (size_t)unit * 16384 + 16 * w + (lane0 & 15); float* dj = (float*)(ws + WS_DSEG) + (size_t)unit * 128; const int g = lane0 >> 4;
#pragma unroll
      for (int kt = 0; kt < 8; ++kt) {
#pragma unroll
          for (int i = 0; i < 4; ++i) sl[(16 * kt + 4 * g + i) * 128] = S[kt][i];
          if (w == 0 && (lane0 & 15) == 0) *(f32x4*)(dj + 16 * kt + 4 * g) = dc[kt]; } }
#undef PA_LOAD
#undef PA_STORE
}
__device__ __forceinline__ void conv_part(const Frame& F, unsigned char* ws, int wg, int nwg) {
    const bf16_t* HZ = (const bf16_t*)(ws + WS_HZ); const bf16_t* HB = (const bf16_t*)(ws + WS_HB); bf16_t* A0 = (bf16_t*)(ws + WS_A0);
    const float* wc = INP(I_EBCONV); const int T = wg * NTHR + F.tid, NT = nwg * NTHR, cg = T & 63;
    float w0[8], w1[8], w2[8];
#pragma unroll
    for (int j = 0; j < 8; ++j) { w0[j] = wc[cg * 8 + j]; w1[j] = wc[512 + cg * 8 + j]; w2[j] = wc[1024 + cg * 8 + j]; }
    for (int u = T; u < (M / 16) * 64; u += NT) { const size_t tok0 = (size_t)(u >> 6) * 16; const bool first = (tok0 & (SEQ - 1)) == 0;
        float z2[8], z1[8];
        if (first) {
#pragma unroll
            for (int j = 0; j < 8; ++j) { z2[j] = 0.f; z1[j] = 0.f; } }
        else { unpack8(*(const u32x4*)(HZ + (tok0 - 2) * 512 + cg * 8), z2); unpack8(*(const u32x4*)(HZ + (tok0 - 1) * 512 + cg * 8), z1); }
        for (int i = 0; i < 16; ++i) { float z0[8], bb[8], o[8]; unpack8(*(const u32x4*)(HZ + (tok0 + i) * 512 + cg * 8), z0); unpack8(*(const u32x4*)(HB + (tok0 + i) * 512 + cg * 8), bb);
#pragma unroll
            for (int j = 0; j < 8; ++j) { o[j] = bb[j] * (w0[j] * z2[j] + w1[j] * z1[j] + w2[j] * z0[j]); z2[j] = z1[j]; z1[j] = z0[j]; }
            *(u32x4*)(A0 + (tok0 + i) * 1024 + 512 + cg * 8) = pack8f(o); }
    }
}
__device__ __forceinline__ void hgrn_finalize(const Frame& F, unsigned char* ws) {
    const bf16_t* HO = (const bf16_t*)(ws + DBG_FIN_SRC); const bf16_t* HG = (const bf16_t*)(ws + WS_HG); bf16_t* A0 = (bf16_t*)(ws + WS_A0);
    const int hh = F.lane >> 4, j = F.lane & 15; float gn[8];
#pragma unroll
    for (int i = 0; i < 8; ++i) gn[i] = INP(I_EAON)[hh * 128 + 8 * j + i];
    for (int tok = F.gw; tok < M; tok += F.NGW) { const size_t off = (size_t)tok * 512 + hh * 128 + 8 * j; float o[8], gt[8], r[8]; unpack8(*(const u32x4*)(HO + off), o); unpack8(*(const u32x4*)(HG + off), gt);
        float ss = 0.f;
#pragma unroll
        for (int i = 0; i < 8; ++i) ss += o[i] * o[i];
        ss = row_sum16(ss);
        const float rr = fast_rsq(ss * (1.0f / 128.f) + 1e-6f);
#pragma unroll
        for (int i = 0; i < 8; ++i) r[i] = o[i] * rr * gn[i] * gt[i];
        *(u32x4*)(A0 + (size_t)tok * 1024 + hh * 128 + 8 * j) = pack8f(r); }
}
__device__ __forceinline__ void gmlp_load(const Frame& F, unsigned char* ws, int unit, u32x4 (&dv)[4]) {
    const int grp = unit & 3, cidx = unit >> 2; const size_t tok0 = (size_t)cidx * 128; const bf16_t* DV = (const bf16_t*)(ws + WS_DV); const int tid = opq(F.tid);
#pragma unroll
    for (int j = 0; j < 4; ++j) { const int pc = tid + 512 * j, s = pc >> 4, ch = pc & 15; dv[j] = *(const u32x4*)(DV + (tok0 + s) * 512 + grp * 128 + ch * 8); }
}
__device__ __forceinline__ void gmlp_unit(const Frame& F, unsigned char* ws, int unit, const u32x4 (&dvc)[4], u32x4 (&dvn)[4], int next_unit) {
    const int grp = unit & 3, cidx = unit >> 2; const size_t tok0 = (size_t)cidx * 128;
    const bf16_t* DV = (const bf16_t*)(ws + WS_DV); const bf16_t* U = (const bf16_t*)(ws + WS_U); const bf16_t* WC = (const bf16_t*)(ws + WS_WC);
    bf16_t* A1 = (bf16_t*)(ws + WS_A1); const float* bs = INP(I_ODBS);
    const int tid = opq(F.tid), lane = tid & 63, w = F.wave, g4 = lane >> 4, c = lane & 15; LAS unsigned char* VN = F.lds;
#pragma unroll
    for (int j = 0; j < 4; ++j) { const int pc = tid + 512 * j, s = pc >> 4, ch = pc & 15; *(LAS u32x4*)(VN + off_b(s, ch)) = dvc[j]; }
    if (next_unit >= 0) gmlp_load(F, ws, next_unit, dvn);
    bf16x8 Bf[4]; const int nks = (w >> 1) + 1;
#pragma unroll
    for (int ks = 0; ks < 4; ++ks) Bf[ks] = *(const bf16x8*)(WC + ((size_t)grp * 128 + 16 * w + c) * 128 + 32 * ks + 8 * g4);
    LDS_BAR();
    const size_t tok = tok0 + 16 * w + c; const float bias = bs[grp * 128 + 16 * w + c];
    u32x2 uua[8];
#pragma unroll
    for (int mt = 0; mt < 8; ++mt) uua[mt] = *(const u32x2*)(U + tok * 512 + grp * 128 + 16 * mt + 4 * g4);
#pragma unroll
    for (int mt = 0; mt < 8; ++mt) { f32x4 acc = (f32x4){0.f, 0.f, 0.f, 0.f};
#pragma unroll
        for (int ks = 0; ks < 4; ++ks) if (ks < nks) { const bf16x8 A = mk8(tr_blk(VN, 32 * ks + 8 * g4, mt, lane), tr_blk(VN, 32 * ks + 8 * g4 + 4, mt, lane)); acc = MFMA16(A, Bf[ks], acc); }
        const int ch = grp * 128 + 16 * mt + 4 * g4; const u32x2 uu = uua[mt];
        f32x4 o; o[0] = bflo(uu.x) * (acc[0] + bias); o[1] = bfhi(uu.x) * (acc[1] + bias); o[2] = bflo(uu.y) * (acc[2] + bias); o[3] = bfhi(uu.y) * (acc[3] + bias);
        *(u32x2*)(A1 + tok * 1536 + 1024 + ch) = pack4(o);
        if (mt & 1) __builtin_amdgcn_sched_barrier(0); }
    LDS_BAR();
}

constexpr int DS_HIST = 0, DS_OIDX = 131072, DS_WQ = 147456, DS_ST = 148480, DS_PEND = 149504, DS_QBAR = 149632;
constexpr unsigned DS_SELALL = 99u, DS_CAP = 512u;
__device__ __forceinline__ unsigned lds_add(LAS unsigned* p, unsigned v) { return __hip_atomic_fetch_add(p, v, __ATOMIC_RELAXED, __HIP_MEMORY_SCOPE_WORKGROUP); }
__device__ __forceinline__ unsigned lds_or(LAS unsigned* p, unsigned v) { return __hip_atomic_fetch_or(p, v, __ATOMIC_RELAXED, __HIP_MEMORY_SCOPE_WORKGROUP); }
__device__ __forceinline__ unsigned f2key(float s) { unsigned u = __float_as_uint(s); if (u == 0x80000000u) u = 0u; return (u & 0x80000000u) ? ~u : (u | 0x80000000u); }

__device__ __forceinline__ int lin_bin(float s) { return (int)__builtin_amdgcn_fmed3f(__builtin_fmaf(s, 128.f, 1024.f), 0.f, 2047.f); }
template <bool V> struct BoolC { static constexpr bool v = V; };
template <int MODE, bool LVL0>
__device__ __forceinline__ void dsa_pass(const bf16x8 (&afr)[4][4], const LAS unsigned char* alin_p, const bf16_t* KI, int t0, LAS unsigned char* L, int w, int lane, int lvl, unsigned short* scr) {
    const int h2 = lane >> 5, c = lane & 31, nkt = (t0 >> 5) + 1;
    LAS unsigned* ST = (LAS unsigned*)(L + DS_ST); const LAS float* WQ = (const LAS float*)(L + DS_WQ);
    LAS unsigned short* OIDX = (LAS unsigned short*)(L + DS_OIDX); LAS unsigned long long* CAND = (LAS unsigned long long*)(L + DS_HIST);
    const int mt0 = (w >> 2) * 4;
    int qa[4][2]; unsigned actm = 0u;
#pragma unroll
    for (int mt = 0; mt < 4; ++mt)
#pragma unroll
        for (int i = 0; i < 2; ++i) { const int q = 4 * (mt0 + mt) + 2 * h2 + i; const unsigned plen = ST[q * 8 + 1], lb1 = ST[q * 8 + 6];
            if (MODE == 0 && LVL0) { qa[mt][i] = 0; actm |= (ST[q * 8 + 5] == 0u) ? (1u << (2 * mt + i)) : 0u; }
            else if (MODE == 0) qa[mt][i] = (ST[q * 8 + 5] == 0u) ? (int)lb1 : -1000;
            else qa[mt][i] = (int)(lb1 | ((plen == DS_SELALL ? 0u : 32u - plen) << 16)); }
    const unsigned sh1 = lvl >= 2 ? 32u - 11u * (unsigned)(lvl - 1) : 0u, sh2 = lvl == 1 ? 21u : (lvl == 2 ? 10u : 0u), bmask = lvl == 3 ? 1023u : 2047u;
    f32x4 wreg[4][2][2];
#pragma unroll
    for (int mt = 0; mt < 4; ++mt)
#pragma unroll
        for (int i = 0; i < 2; ++i) { const int q = 4 * (mt0 + mt) + 2 * h2 + i; if (MODE != 1) { wreg[mt][i][0] = *(const LAS f32x4*)(WQ + q * 8); wreg[mt][i][1] = *(const LAS f32x4*)(WQ + q * 8 + 4); } }
    LAS unsigned char* hbase = L + DS_HIST + (2 * h2 + 4 * mt0) * 4096;
    constexpr bool PF = false && (MODE == 0 && LVL0);
    bf16x8 bnx[4];
    if (PF && (w & 3) < nkt) {
#pragma unroll
        for (int ks = 0; ks < 4; ++ks) bnx[ks] = *(const bf16x8*)(KI + (size_t)((w & 3) * 32 + c) * 64 + 16 * ks + 8 * h2); }
    for (int kt = (w & 3); kt < nkt; kt += 4) {
        const int key0 = kt * 32; const bool lastt = (kt == nkt - 1);
        const int c2 = (lastt ? c : 0) - 2 * h2;
        bf16x8 bfr[4];
        if (PF) {
#pragma unroll
            for (int ks = 0; ks < 4; ++ks) bfr[ks] = bnx[ks];
            if (kt + 4 < nkt) {
#pragma unroll
                for (int ks = 0; ks < 4; ++ks) bnx[ks] = *(const bf16x8*)(KI + (size_t)(key0 + 128 + c) * 64 + 16 * ks + 8 * h2); }
        } else {
#pragma unroll
            for (int ks = 0; ks < 4; ++ks) bfr[ks] = *(const bf16x8*)(KI + (size_t)(key0 + c) * 64 + 16 * ks + 8 * h2); }
        const unsigned voffb = (unsigned)(((2 * h2 + 4 * mt0) * 8192 + key0 + c) * 2);
        auto tile_body = [&](auto mc_) { constexpr bool MASKED = decltype(mc_)::v;
        f32x16 accl;
#pragma unroll
        for (int i = 0; i < 16; ++i) accl[i] = 0.f;
#pragma unroll
        for (int ks = 0; ks < 4; ++ks) accl = __builtin_amdgcn_mfma_f32_32x32x16_bf16(*(const LAS bf16x8*)(alin_p + 32 * ks), bfr[ks], accl, 0, 0, 0);
#pragma unroll
        for (int mt = 0; mt < 4; ++mt) {
            f32x16 acc;
#pragma unroll
            for (int i = 0; i < 16; ++i) acc[i] = 0.f;
#pragma unroll
            for (int ks = 0; ks < 4; ++ks) acc = __builtin_amdgcn_mfma_f32_32x32x16_bf16(afr[mt][ks], bfr[ks], acc, 0, 0, 0);
#pragma unroll
            for (int i = 0; i < 2; ++i) {
                const int q = 4 * (mt0 + mt) + 2 * h2 + i, qu = 4 * (mt0 + mt) + i;
                const f32x4 wa = (MODE != 1) ? wreg[mt][i][0] : *(const LAS f32x4*)(WQ + q * 8), wb = (MODE != 1) ? wreg[mt][i][1] : *(const LAS f32x4*)(WQ + q * 8 + 4);
                float s = wa[0] * __builtin_fabsf(acc[8 * i + 0]);
                s = __builtin_fmaf(wa[1], __builtin_fabsf(acc[8 * i + 1]), s); s = __builtin_fmaf(wa[2], __builtin_fabsf(acc[8 * i + 2]), s); s = __builtin_fmaf(wa[3], __builtin_fabsf(acc[8 * i + 3]), s);
                s = __builtin_fmaf(wb[0], __builtin_fabsf(acc[8 * i + 4]), s); s = __builtin_fmaf(wb[1], __builtin_fabsf(acc[8 * i + 5]), s); s = __builtin_fmaf(wb[2], __builtin_fabsf(acc[8 * i + 6]), s); s = __builtin_fmaf(wb[3], __builtin_fabsf(acc[8 * i + 7]), s);
                s = 0.5f * (s + accl[2 * mt + i]);
                const _Float16 hs = (_Float16)s; s = (float)hs;
                const unsigned lb = (unsigned)lin_bin(s);
                if (MODE == 0 && LVL0) *(unsigned short*)((unsigned char*)(scr + (4 * mt + i) * 8192) + voffb) = __builtin_bit_cast(unsigned short, hs);
                if (MODE == 0 && LVL0) {
                    unsigned inc = 1u << ((lb & 1u) << 4); if (MASKED) inc = (c2 <= qu) ? inc : 0u;
                    lds_add((LAS unsigned*)(hbase + (4 * mt + i) * 4096 + (lb >> 1) * 4), inc);
                } else if (MODE == 0) {
                    const unsigned key = f2key(s);
                    if (c2 <= qu && (int)(lb + 1u) == qa[mt][i] && (lvl == 1 || (key >> sh1) == ST[q * 8 + 0])) { const unsigned bin = (key >> sh2) & bmask; lds_add((LAS unsigned*)(hbase + (4 * mt + i) * 4096 + (bin >> 1) * 4), 1u << (16u * (bin & 1u))); }
                } else {
                    const unsigned st = (unsigned)qa[mt][i], thr1 = st & 0xffffu, lb1 = lb + 1u;
                    if (c2 <= qu && lb1 >= thr1) {
                        const unsigned key = f2key(s); bool sel = lb1 > thr1;
                        if (!sel) { const unsigned pfx = (unsigned)((unsigned long long)key >> (st >> 16)), px = ST[q * 8 + 0]; if (pfx < px) continue; sel = pfx > px; }
                        if (sel) { const unsigned slot = lds_add(&ST[q * 8 + 3], 1u); if (slot < 256u) OIDX[q * 256 + slot] = (unsigned short)(key0 + c); }
                        else { const unsigned slot = lds_add(&ST[q * 8 + 4], 1u); if (slot < DS_CAP) CAND[q * 512 + slot] = ((unsigned long long)key << 13) | (unsigned long long)(8191 - (key0 + c)); } }
                }
            }
        }
        };
        if (MODE == 0 && LVL0 && !lastt) tile_body(BoolC<false>{}); else tile_body(BoolC<true>{});
    }
}

__device__ __forceinline__ void dsa_resolve(LAS unsigned char* L, const LAS unsigned long long* CANDq, int q, int lane) {
    LAS unsigned* ST = (LAS unsigned*)(L + DS_ST); LAS unsigned short* OIDX = (LAS unsigned short*)(L + DS_OIDX);
    const unsigned plen = ST[q * 8 + 1];
    if (plen == DS_SELALL) return;
    const unsigned need = ST[q * 8 + 2], ncand = ST[q * 8 + 4], n = ncand < DS_CAP ? ncand : DS_CAP, prefix = ST[q * 8 + 0]; const int nj = (int)((n + 63u) >> 6);
    if (n <= 64u) {
        const unsigned long long v = (unsigned)lane < n ? CANDq[lane] : 0ull; const unsigned vlo = (unsigned)v, vhi = (unsigned)(v >> 32); unsigned rank = 0;
        for (unsigned j = 0; j < n; ++j) { const unsigned olo = __builtin_amdgcn_readlane(vlo, j), ohi = __builtin_amdgcn_readlane(vhi, j); const unsigned long long o = ((unsigned long long)ohi << 32) | olo; rank += (o > v) ? 1u : 0u; }
        if ((unsigned)lane < n && rank < need) { const unsigned slot = lds_add(&ST[q * 8 + 3], 1u); if (slot < 256u) OIDX[q * 256 + slot] = (unsigned short)(8191u - (unsigned)(v & 8191ull)); }
    } else {
        unsigned long long v[8];
#pragma unroll
        for (int j = 0; j < 8; ++j) { const unsigned idx = lane + 64 * j; v[j] = (j < nj && idx < n) ? CANDq[idx] : 0ull; }
        unsigned long long T = (plen >= 32u) ? ((unsigned long long)prefix << 13) : (plen == 0u ? 0ull : ((unsigned long long)prefix << (45u - plen)));
        for (int bit = 44 - (int)plen; bit >= 0; --bit) { const unsigned long long trial = T | (1ull << bit); unsigned cnt = 0;
#pragma unroll
            for (int j = 0; j < 8; ++j) if (j < nj) cnt += (unsigned)__popcll(__ballot(v[j] >= trial));
            if (cnt >= need) T = trial; }
#pragma unroll
        for (int j = 0; j < 8; ++j) if (j < nj && v[j] >= T && v[j] != 0ull) { const unsigned slot = lds_add(&ST[q * 8 + 3], 1u); if (slot < 256u) OIDX[q * 256 + slot] = (unsigned short)(8191u - (unsigned)(v[j] & 8191ull)); }
    }
}
__device__ __forceinline__ unsigned thresh_half(int T) { const _Float16 h = (_Float16)((float)(T - 1024) * (1.0f / 128.f)); const unsigned b = (unsigned)__builtin_bit_cast(unsigned short, h);
    return T <= 0 ? 0xFC00u : (T >= 2048 ? 0x7C00u : (T == 1024 ? 0x8004u : b)); }
typedef _Float16 half2_t __attribute__((ext_vector_type(2)));
template <int CTRL> __device__ __forceinline__ unsigned dppu(unsigned v) { return (unsigned)__builtin_amdgcn_update_dpp(0, (int)v, CTRL, 0xf, 0xf, true); }
__device__ __forceinline__ unsigned wave_incl_scan(unsigned v) {
    v += dppu<0x111>(v); v += dppu<0x112>(v); v += dppu<0x114>(v); v += dppu<0x118>(v);
    v += (unsigned)__builtin_amdgcn_update_dpp(0, (int)v, 0x142, 0xA, 0xF, false); v += (unsigned)__builtin_amdgcn_update_dpp(0, (int)v, 0x143, 0xC, 0xF, false); return v; }
__device__ __forceinline__ void dsa_emit_stored(const unsigned short* scr, int t0, LAS unsigned char* L, int w, int lane) {
    LAS unsigned* ST = (LAS unsigned*)(L + DS_ST); LAS unsigned short* OIDX = (LAS unsigned short*)(L + DS_OIDX);
    LAS unsigned* LIST = (LAS unsigned*)(L + DS_HIST + w * 16384); LAS unsigned long long* CANDW = (LAS unsigned long long*)(L + DS_HIST + w * 16384 + 4096);
    constexpr int RD = 8;
    u32x4 buf[RD];
    if (ST[(4 * w) * 8 + 1] != DS_SELALL) {
        const unsigned short* row0 = scr + (4 * w) * 8192 + lane * 8; const int nr0 = ((t0 + 4 * w) >> 9) + 1;
#pragma unroll
        for (int u = 0; u < RD; ++u) if (u < nr0) buf[u] = *(const u32x4*)(row0 + u * 512); }
    for (int qi = 0; qi < 4; ++qi) { const int q = 4 * w + qi, t = t0 + q; const unsigned plen = ST[q * 8 + 1];
        if (plen == DS_SELALL) { for (int i = lane; i <= t; i += 64) OIDX[q * 256 + i] = (unsigned short)i; if (lane == 0) ST[q * 8 + 3] = (unsigned)(t + 1); continue; }
        const unsigned thr1 = ST[q * 8 + 6]; const unsigned h0 = thresh_half((int)thr1 - 1), h1 = thresh_half((int)thr1);
        const unsigned nh0 = (h0 ^ 0x8000u) * 0x10001u; const half2_t nh0v = __builtin_bit_cast(half2_t, nh0);
        const unsigned short* row = scr + q * 8192 + lane * 8; const int nr = (t >> 9) + 1;
        unsigned cnt = 0u;
        for (int r0 = 0; r0 < nr; r0 += RD) {
#pragma unroll
          for (int u = 0; u < RD; ++u) { const int r = r0 + u; if (r < nr) { const u32x4 cur = buf[u]; if (r + RD < nr) buf[u] = *(const u32x4*)(row + (r + RD) * 512);
            const unsigned idx0 = (unsigned)(r * 512 + lane * 8);
            unsigned x[4];
#pragma unroll
            for (int k = 0; k < 4; ++k) { const unsigned ck = cur[k]; x[k] = __builtin_bit_cast(unsigned, __builtin_bit_cast(half2_t, ck) + nh0v); }
            const unsigned f01 = __builtin_amdgcn_perm(x[1], x[0], 0x07050301u) & 0x80808080u, f23 = __builtin_amdgcn_perm(x[3], x[2], 0x07050301u) & 0x80808080u;
            unsigned pm = (f01 | (f23 >> 1)) ^ 0xC0C0C0C0u;
            if (r == nr - 1) { const int nv = t - (int)idx0 + 1, na = nv < 0 ? 0 : (nv > 4 ? 4 : nv), nb = nv - 4 < 0 ? 0 : (nv - 4 > 4 ? 4 : nv - 4);
                pm &= (0x80808080u & (unsigned)((1ull << (8 * na)) - 1ull)) | (0x40404040u & (unsigned)((1ull << (8 * nb)) - 1ull)); }
            const unsigned c = (unsigned)__builtin_popcount(pm); const unsigned inc = wave_incl_scan(c);
            unsigned base = cnt + inc - c; cnt += __builtin_amdgcn_readlane(inc, 63);
            while (pm) { const unsigned b = (unsigned)__builtin_ctz(pm); pm &= pm - 1u; const unsigned k = b >> 3, hq = (~b) & 1u;
                const unsigned long long pr = hq ? (((unsigned long long)cur[3] << 32) | cur[2]) : (((unsigned long long)cur[1] << 32) | cur[0]);
                const unsigned e = ((unsigned)(pr >> (16u * k)) << 16) | (idx0 + k + 4u * hq);
                if (base < 1024u) LIST[base] = e; ++base; }
          } } }
        if (qi < 3) { const unsigned short* rown = row + 8192; const int nrn = ((t + 1) >> 9) + 1;
#pragma unroll
            for (int u = 0; u < RD; ++u) if (u < nrn) buf[u] = *(const u32x4*)(rown + u * 512); }
        LDS_WAIT();
        const float h1f = (float)__builtin_bit_cast(_Float16, (unsigned short)h1); const unsigned n = cnt < 1024u ? cnt : 1024u; unsigned nsel = 0u, ncand = 0u;
        for (unsigned i0 = 0; i0 < n; i0 += 64u) { const unsigned i = i0 + (unsigned)lane; const bool in = i < n; const unsigned e = in ? LIST[i] : 0u;
            const float sr = (float)__builtin_bit_cast(_Float16, (unsigned short)(e >> 16)); const bool sel = in && sr >= h1f, cd = in && !(sr >= h1f);
            const unsigned long long m = __ballot((int)sel), mc = __ballot((int)cd);
            if (sel) { const unsigned slot = nsel + __builtin_amdgcn_mbcnt_hi((unsigned)(m >> 32), __builtin_amdgcn_mbcnt_lo((unsigned)m, 0u)); if (slot < 256u) OIDX[q * 256 + slot] = (unsigned short)(e & 8191u); }
            if (cd) { const unsigned slot = ncand + __builtin_amdgcn_mbcnt_hi((unsigned)(mc >> 32), __builtin_amdgcn_mbcnt_lo((unsigned)mc, 0u));
                if (slot < DS_CAP) CANDW[slot] = ((unsigned long long)f2key(sr) << 13) | (unsigned long long)(8191u - (e & 8191u)); }
            nsel += (unsigned)__popcll(m); ncand += (unsigned)__popcll(mc); }
        if (lane == 0) { ST[q * 8 + 3] = nsel; ST[q * 8 + 4] = ncand; }
        LDS_WAIT();
        dsa_resolve(L, CANDW, q, lane);
        LDS_WAIT();
    }
}

__device__ __forceinline__ void dsa_tile(const Frame& F, unsigned char* ws, int b, int tile) {
    LAS unsigned char* L = F.lds; const int tid = opq(F.tid), lane = tid & 63, w = F.wave;
    const int t0 = tile * 32; const size_t tokbase = (size_t)b * SEQ + t0;
    const bf16_t* QI = (const bf16_t*)(ws + WS_QI); const bf16_t* KI = (const bf16_t*)(ws + WS_KIDXN) + (size_t)b * SEQ * 64; const float* WIDX = (const float*)(ws + WS_WIDX);
    const bf16_t* QL = (const bf16_t*)(ws + WS_QL); const bf16_t* CKV = (const bf16_t*)(ws + WS_CKVN) + (size_t)b * SEQ * 128; bf16_t* A1 = (bf16_t*)(ws + WS_A1);
    LAS unsigned* HIST = (LAS unsigned*)(L + DS_HIST); LAS unsigned* ST = (LAS unsigned*)(L + DS_ST); LAS float* WQ = (LAS float*)(L + DS_WQ);
    LAS unsigned short* OIDX = (LAS unsigned short*)(L + DS_OIDX); LAS unsigned long long* CAND = (LAS unsigned long long*)(L + DS_HIST); LAS unsigned* PEND = (LAS unsigned*)(L + DS_PEND);
    unsigned short* scr = (unsigned short*)(ws + WS_SCR + (size_t)opq_s((int)blockIdx.x) * 524288);
    if (tid < 256) WQ[tid] = WIDX[tokbase * 8 + tid];
    if (tid < 8) PEND[tid] = 0u;
    LDS_BAR();
    if (tid < 32) { const bool selall = (t0 + tid + 1) <= 256; ST[tid * 8 + 0] = 0u; ST[tid * 8 + 1] = selall ? DS_SELALL : 0u; ST[tid * 8 + 2] = 256u; ST[tid * 8 + 3] = 0u; ST[tid * 8 + 4] = 0u; ST[tid * 8 + 5] = selall ? 1u : 0u; ST[tid * 8 + 6] = 0u;
        if (!selall) lds_or(&PEND[0], 1u); }
    {
      const int q = tid >> 4, d0 = (tid & 15) * 4; f32x4 acc4 = (f32x4){0.f, 0.f, 0.f, 0.f};
#pragma unroll
      for (int hh = 0; hh < 8; ++hh) { const u32x2 v = *(const u32x2*)(QI + (tokbase + q) * 512 + hh * 64 + d0); const float wv = WQ[q * 8 + hh];
          acc4[0] += wv * bflo(v.x); acc4[1] += wv * bfhi(v.x); acc4[2] += wv * bflo(v.y); acc4[3] += wv * bfhi(v.y); }
      *(LAS u32x2*)(L + DS_QBAR + q * 128 + d0 * 2) = pack4(acc4); }
#pragma unroll
    for (int j = 0; j < 16; ++j) *(LAS u32x4*)(L + DS_HIST + (size_t)(tid + 512 * j) * 16) = (u32x4){0u, 0u, 0u, 0u};
    bf16x8 afr[4][4];
    { const int h2 = lane >> 5, rho = lane & 31, ql = 2 * ((rho >> 2) & 1) + (rho >> 4), hd = 4 * ((rho >> 3) & 1) + (rho & 3);
#pragma unroll
      for (int mt = 0; mt < 4; ++mt)
#pragma unroll
          for (int ks = 0; ks < 4; ++ks) afr[mt][ks] = *(const bf16x8*)(QI + (tokbase + 4 * ((w >> 2) * 4 + mt) + ql) * 512 + hd * 64 + 16 * ks + 8 * h2); }
    LDS_BAR();
    const LAS unsigned char* alin;
    { const int h2 = lane >> 5, rho = lane & 15, hq = (rho >> 2) & 1, r = 4 * (rho >> 3) + (rho & 3), qq = 4 * ((w >> 2) * 4 + (r >> 1)) + 2 * hq + (r & 1); alin = L + DS_QBAR + qq * 128 + 16 * h2; }
    for (int lvl = 0; lvl < 4; ++lvl) {
        if (PEND[lvl] == 0u) break;
        if (lvl == 0) dsa_pass<0, true>(afr, alin, KI, t0, L, w, lane, 0, scr); else dsa_pass<0, false>(afr, alin, KI, t0, L, w, lane, lvl, scr);
#if DSA_DUP & 4
        if (lvl == 0) { LDS_BAR();
#pragma unroll
            for (int j = 0; j < 16; ++j) *(LAS u32x4*)(L + DS_HIST + (size_t)(tid + 512 * j) * 16) = (u32x4){0u, 0u, 0u, 0u};
            LDS_BAR(); dsa_pass<0, true>(afr, alin, KI, t0, L, w, lane, 0, scr); }
#endif
        WG_BAR();
        for (int qi = 0; qi < 4; ++qi) { const int q = 4 * w + qi;
            if (ST[q * 8 + 5] == 0u) { const unsigned plen = ST[q * 8 + 1], need = ST[q * 8 + 2], prefix = ST[q * 8 + 0];
                unsigned cnt = 0;
#pragma unroll
                for (int j = 0; j < 4; ++j) { const u32x4 v = *(const LAS u32x4*)(HIST + q * 1024 + lane * 16 + 4 * j);
                    cnt += (v.x & 0xffffu) + (v.x >> 16) + (v.y & 0xffffu) + (v.y >> 16) + (v.z & 0xffffu) + (v.z >> 16) + (v.w & 0xffffu) + (v.w >> 16); }
                const unsigned pre = wave_incl_scan(cnt), tot = (unsigned)__builtin_amdgcn_readlane((int)pre, 63);
                const unsigned s = tot - pre + cnt;
                const unsigned excl = s - cnt;
                if (excl < need && need <= s) { unsigned run = excl, thr = lane * 32, cin = 0;
                    for (int bin = lane * 32 + 31; bin >= lane * 32; --bin) { const unsigned cw = HIST[q * 1024 + (bin >> 1)], cb = (bin & 1) ? (cw >> 16) : (cw & 0xffffu);
                        if (run + cb >= need) { thr = bin; cin = cb; break; } run += cb; }
                    bool d;
                    if (lvl == 0) { ST[q * 8 + 6] = thr + 1u; d = cin <= DS_CAP; }
                    else { const unsigned nbits = lvl < 3 ? 11u : 10u, np = plen + nbits; d = (cin <= DS_CAP) || (np >= 32u); ST[q * 8 + 0] = (prefix << nbits) | thr; ST[q * 8 + 1] = np; }
                    ST[q * 8 + 2] = need - run; ST[q * 8 + 5] = d ? 1u : 0u;
                    if (!d) lds_or(&PEND[lvl + 1], 1u); }
            }
            LDS_WAIT();
#pragma unroll
            for (int j = 0; j < 4; ++j) *(LAS u32x4*)(HIST + q * 1024 + lane * 16 + 4 * j) = (u32x4){0u, 0u, 0u, 0u};
        }
        LDS_BAR();
    }
#if DSA_DUP & 2
    if (PEND[1] == 0u) dsa_emit_stored(scr, t0, L, w, opq(lane));
#endif
    if (PEND[1] == 0u) dsa_emit_stored(scr, t0, L, w, lane);
    else { dsa_pass<1, false>(afr, alin, KI, t0, L, w, lane, 0, scr); LDS_BAR();
        for (int qi = 0; qi < 4; ++qi) dsa_resolve(L, CAND + (4 * w + qi) * 512, 4 * w + qi, lane); }
    LDS_WAIT();
    LAS unsigned char* KVb = L + DS_HIST + w * 16384;
    const int lane0a = lane;
    {
        const int head = lane0a & 7;
        int gq = 0, gk = 0, cq = 0, ck = 0;
#define DSA_NS(qi_) ({ unsigned n_ = ST[(4 * w + (qi_)) * 8 + 3]; n_ = n_ < 256u ? n_ : 256u; (unsigned)__builtin_amdgcn_readfirstlane((int)n_); })
#define DSA_ADV(q_, k_) do { const unsigned nn_ = DSA_NS(q_); if ((unsigned)(64 * ((k_) + 1)) < nn_) ++(k_); else { ++(q_); (k_) = 0; } } while (0)
#define DSA_GATHER(buf_) do { const int lg_ = opq(lane0a); const int q_ = 4 * w + gq; const unsigned ns_ = DSA_NS(gq); _Pragma("unroll") for (int jj = 0; jj < 16; ++jj) { const int pc = lg_ + 64 * jj, row = pc >> 4, ch = pc & 15; \
            const unsigned slot = 64 * gk + row; const unsigned kidx = slot < ns_ ? (unsigned)OIDX[q_ * 256 + slot] : 0u; buf_[jj] = *(const u32x4*)(CKV + (size_t)kidx * 128 + ch * 8); } DSA_ADV(gq, gk); } while (0)
        u32x4 tA[16], tB[16];
        bf16x8 bq[4]; float m_run = -1.0e30f, l_part = 0.f; f32x4 O[8];
        DSA_GATHER(tA);
        if (gq < 4) DSA_GATHER(tB);
        { const int g0 = lane0a >> 4;
#pragma unroll
          for (int ks = 0; ks < 4; ++ks) bq[ks] = *(const bf16x8*)(QL + (tokbase + 4 * w) * 1024 + head * 128 + 32 * ks + 8 * g0); }
        auto chunk = [&](const u32x4 (&buf)[16], bool more) {
            const int lane = opq(lane0a), g = lane >> 4, n16 = lane & 15;
            const int q = 4 * w + cq; const size_t tok = tokbase + q; const unsigned nsel = DSA_NS(cq); const int kc = ck;
            const bool lastc = (unsigned)(64 * (kc + 1)) >= nsel;
            (void)more;
            if (kc == 0) { m_run = -1.0e30f; l_part = 0.f;
#pragma unroll
                for (int mt = 0; mt < 8; ++mt) O[mt] = (f32x4){0.f, 0.f, 0.f, 0.f}; }
            f32x4 sc[4]; float cmax = -1.0e30f;
#pragma unroll
            for (int jt = 0; jt < 4; ++jt) { sc[jt] = (f32x4){0.f, 0.f, 0.f, 0.f};
#pragma unroll
                for (int ks = 0; ks < 4; ++ks) { const bf16x8 A = *(const LAS bf16x8*)(KVb + off_b(16 * jt + n16, 4 * ks + g)); sc[jt] = MFMA16(A, bq[ks], sc[jt]); }
#pragma unroll
                for (int i = 0; i < 4; ++i) { const unsigned slot = 64 * kc + 16 * jt + 4 * g + i; if (slot >= nsel) sc[jt][i] = -1.0e30f; cmax = fmaxf(cmax, sc[jt][i]); } }
            if (lastc && cq < 3) {
#pragma unroll
                for (int ks = 0; ks < 4; ++ks) bq[ks] = *(const bf16x8*)(QL + (tok + 1) * 1024 + (n16 & 7) * 128 + 32 * ks + 8 * g); }
            cmax = max_fq(cmax);
            const float m_new = fmaxf(m_run, cmax), alpha = fast_exp2((m_run - m_new) * 1.4426950408889634f); float ps = 0.f;
#pragma unroll
            for (int jt = 0; jt < 4; ++jt)
#pragma unroll
                for (int i = 0; i < 4; ++i) { const float p = fast_exp2((sc[jt][i] - m_new) * 1.4426950408889634f); sc[jt][i] = p; ps += p; }
            l_part = l_part * alpha + ps; m_run = m_new;
            bf16x8 Pf[2];
#pragma unroll
            for (int k2 = 0; k2 < 2; ++k2) Pf[k2] = __builtin_bit_cast(bf16x8, pack8(sc[2 * k2], sc[2 * k2 + 1]));
#pragma unroll
            for (int mt = 0; mt < 8; ++mt) { O[mt] = O[mt] * alpha;
#pragma unroll
                for (int k2 = 0; k2 < 2; ++k2) { const bf16x8 A = mk8(tr_blk(KVb, 32 * k2 + 4 * g, mt, lane), tr_blk(KVb, 32 * k2 + 16 + 4 * g, mt, lane)); O[mt] = MFMA16(A, Pf[k2], O[mt]); } }
            if (lastc) { const float inv = fast_rcp(red_fq(l_part));
                if (n16 < 8) {
#pragma unroll
                    for (int mt = 0; mt < 8; ++mt) *(u32x2*)(A1 + tok * 1536 + (n16 & 7) * 128 + 16 * mt + 4 * g) = pack4(O[mt] * inv); } }
            DSA_ADV(cq, ck);
        };
#define DSA_STAGE(buf_) do { const int ls_ = opq(lane0a); _Pragma("unroll") for (int jj = 0; jj < 16; ++jj) { const int pc = ls_ + 64 * jj, row = pc >> 4, ch = pc & 15; *(LAS u32x4*)(KVb + off_b(row, ch)) = buf_[jj]; } } while (0)
        for (;;) {
            DSA_STAGE(tA); if (gq < 4) DSA_GATHER(tA); chunk(tA, true); if (cq >= 4) break;
            DSA_STAGE(tB); if (gq < 4) DSA_GATHER(tB); chunk(tB, true); if (cq >= 4) break;
        }
#undef DSA_STAGE
#undef DSA_GATHER
#undef DSA_ADV
#undef DSA_NS
    }
    LDS_BAR();
}

#define NOINL __forceinline__
__device__ __forceinline__ Frame mk_frame(LAS unsigned char* lds) { Frame F; F.lds = lds; int t_ = threadIdx.x; asm volatile("" : "+v"(t_)); F.tid = t_; F.lane = F.tid & 63; F.wave = __builtin_amdgcn_readfirstlane(F.tid >> 6);
    F.G = gridDim.x; F.gw = blockIdx.x * NWAVES + F.wave; F.NGW = F.G * NWAVES; return F; }
__device__ NOINL void ph_prologue(LAS unsigned char* lds, unsigned char* ws) { const Frame F = mk_frame(lds); p0_prologue(F, ws); }
__device__ NOINL void ph_gemm_bf(LAS unsigned char* lds, unsigned char* ws, int which, int Gs, int cs_, int aux) {
    const int cs = opq_s(cs_);
    pg8::Gemm g; pg8::StaticOrder S; EpiBf E; E.split_pn = 99; E.O2 = nullptr; E.ldc2 = 0; E.rsv = nullptr; E.rs_mode = 0; E.pn_stride = 256;
    if (which == 0 || which == 7) { g = pg8::plain_gemm((const bf16_t*)(ws + WS_MEMB), (const bf16_t*)(ws + (which == 0 ? WS_W_XKT : WS_W_XVT)), 1024); S.init(8, 8, Gs, cs);
        E.O = (bf16_t*)(ws + (which == 0 ? WS_KM : WS_VT)); E.ldc = 2048; E.rsv = (const float*)(ws + WS_MEMRS); E.rs_mode = 2; }
    else if (which == 5) { g = pg8::plain_gemm((const bf16_t*)(ws + WS_CQN), (const bf16_t*)(ws + WS_W_Q1T), 256); if (Gs < 0) S.init_panel(6, cs); else S.init(256, 6, Gs, cs); E.O = (bf16_t*)(ws + WS_QL); E.ldc = 1024; E.split_pn = 4; E.O2 = (bf16_t*)(ws + WS_QI); E.ldc2 = 512; }
    else if (which == 6) { g = pg8::plain_gemm((const bf16_t*)(ws + WS_XB), (const bf16_t*)(ws + WS_W_IN1T), 1024); if (Gs < 0) S.init_panel(6, cs); else S.init(256, 6, Gs, cs); E.O = (bf16_t*)(ws + WS_P1RAW); E.ldc = 1536; E.rsv = (const float*)(ws + WS_RSP) + (size_t)3 * M * 4; E.rs_mode = 1; }
    else if (which == 8) { const int L = aux >> 2, h = aux & 3;
        g.A = (const bf16_t*)(ws + WS_KM) + (size_t)L * 1024 + h * 256; g.lda = 2048; g.a_pm = (size_t)256 * 2048 * 2; g.a_pn = 0;
        g.Bt = (const bf16_t*)(ws + WS_W_XQT) + (size_t)L * D * D + h * 256; g.ldb = 1024; g.b_pn = (size_t)256 * 1024 * 2; g.b_pm = 0; g.b_sh = 0; g.K = 256; S.init(8, 4, Gs, cs);
        E.O = (bf16_t*)(ws + WS_WQK) + (size_t)h * 2048 * 1024; E.ldc = 1024; }
    else { const int L = aux >> 2, h = aux & 3;
        g.A = (const bf16_t*)(ws + WS_W_XOT) + (size_t)L * D * D + h * 256; g.lda = 1024; g.a_pm = (size_t)256 * 1024 * 2; g.a_pn = 0;
        g.Bt = (const bf16_t*)(ws + WS_VT) + (size_t)L * 1024 + h * 256; g.ldb = 2048; g.b_pn = (size_t)256 * 2048 * 2; g.b_pm = 0; g.b_sh = 0; g.K = 256; S.init(4, 8, Gs, cs);
        E.O = (bf16_t*)(ws + WS_VWOT) + h * 256; E.ldc = 1024; E.pn_stride = 1024 * 1024; }
    pg8::gemm_phase(lds, g, S, E);
}
__device__ NOINL void ph_gemm_res(LAS unsigned char* lds, unsigned char* ws, float* out, const float* xin, int which) {
    pg8::Gemm g; pg8::StaticOrder S; if (which == 5 && gridDim.x == 256) S.init_panel(4, opq_s((int)blockIdx.x)); else S.init(256, 4, (int)gridDim.x, opq_s((int)blockIdx.x)); int slot;
    if (which == 0) { g = pg8::plain_gemm((const bf16_t*)(ws + (DBG_A0SRC == 1 ? WS_XB : WS_A0)), (const bf16_t*)(ws + WS_W_OUT0T), 1024); slot = 1;
        if (DBG_A0SRC == 2) { g.A += 512; g.K = 512; } if (DBG_A0SRC == 3) { g.K = 512; } }
    else if (which == 1) { g = pg8::plain_gemm((const bf16_t*)(ws + WS_A1), (const bf16_t*)(ws + WS_W_OUT1T), 1536); slot = 4; }
    else if (which <= 3) { const int L = which - 2; g = pg8::plain_gemm((const bf16_t*)(ws + WS_P), (const bf16_t*)(ws + WS_VWOT), 1024); g.b_pm = (size_t)1024 * 1024 * 2; g.b_sh = 5; slot = L ? 5 : 2; }
    else { const int L = which - 4; g = pg8::plain_gemm((const bf16_t*)(ws + WS_ACT), (const bf16_t*)(ws + WS_W_2T) + (size_t)L * D * FF, FF); slot = L ? 6 : 3; }
    (void)out; (void)xin; EpiRes E{(bf16_t*)(ws + WS_XB), (float*)(ws + WS_RSP) + (size_t)slot * M * 4}; pg8::gemm_phase(lds, g, S, E);
}
__device__ NOINL void ph_gemm_in0(LAS unsigned char* lds, unsigned char* ws) {
    pg8::Gemm g = pg8::plain_gemm((const bf16_t*)(ws + WS_XB), (const bf16_t*)(ws + WS_W_IN0T), 1024); pg8::StaticOrder S; S.init(256, 14, (int)gridDim.x, opq_s((int)blockIdx.x));
    EpiIn0 E{ws};
    pg8::gemm_phase(lds, g, S, E);
}
__device__ NOINL void ph_gemm_s(LAS unsigned char* lds, unsigned char* ws, int L) {
    pg8::Gemm g = pg8::plain_gemm((const bf16_t*)(ws + WS_XB), (const bf16_t*)(ws + WS_WQK), 1024); g.b_pn = (size_t)8 * 256 * 1024 * 2; g.b_pm = (size_t)256 * 1024 * 2; g.b_sh = 5;
    pg8::StaticOrder S; S.init(256, 4, (int)gridDim.x, opq_s((int)blockIdx.x));
    EpiS E{(bf16_t*)(ws + WS_P), (const float*)(ws + WS_RSP) + (size_t)(L ? 4 : 1) * M * 4}; pg8::gemm_phase(lds, g, S, E);
}
__device__ NOINL void ph_gemm_ffn1(LAS unsigned char* lds, unsigned char* ws, int L) {
    pg8::Gemm g = pg8::plain_gemm((const bf16_t*)(ws + WS_XB), (const bf16_t*)(ws + WS_W_13T) + (size_t)L * 5632 * D, 1024); pg8::StaticOrder S; S.init(256, 22, (int)gridDim.x, opq_s((int)blockIdx.x));
    EpiFfn1 E{(bf16_t*)(ws + WS_ACT), (const float*)(ws + WS_RSP) + (size_t)(L ? 5 : 2) * M * 4}; pg8::gemm_phase(lds, g, S, E);
}

__device__ NOINL void ph_post1(LAS unsigned char* lds, unsigned char* ws, int row0, int nrows) { const Frame F = mk_frame(lds);
    const bf16_t* P1 = (const bf16_t*)(ws + WS_P1RAW); bf16_t* CQN = (bf16_t*)(ws + WS_CQN); bf16_t* CKVN = (bf16_t*)(ws + WS_CKVN); bf16_t* KIDXN = (bf16_t*)(ws + WS_KIDXN); float* WIDX = (float*)(ws + WS_WIDX);
    bf16_t* U = (bf16_t*)(ws + WS_U); bf16_t* DVN = (bf16_t*)(ws + WS_DV);
    const int lane = F.lane; const bool is_cq = lane < 32, is_kv = lane >= 32 && lane < 48, is_ki = lane >= 48 && lane < 56, is_w = lane == 56;
    float g0[8], b0[8], vg[8], vb[8];
#pragma unroll
    for (int i = 0; i < 8; ++i) { g0[i] = is_kv ? INP(I_OCKVN)[(lane - 32) * 8 + i] : (is_ki ? INP(I_OIDXKG)[(lane - 48) * 8 + i] : 1.f); b0[i] = is_ki ? INP(I_OIDXKB)[(lane - 48) * 8 + i] : 0.f;
        vg[i] = INP(I_ODVG)[lane * 8 + i]; vb[i] = INP(I_ODVB)[lane * 8 + i]; }
    const int rstep = (nrows == M ? F.NGW : NWAVES), rfirst = row0 + (nrows == M ? F.gw : F.wave);
    u32x4 nx0, nx1, nx2;
    if (rfirst < row0 + nrows) { const bf16_t* pr = P1 + (size_t)rfirst * 1536; nx0 = *(const u32x4*)(pr + lane * 8); nx1 = *(const u32x4*)(pr + 512 + lane * 8); nx2 = *(const u32x4*)(pr + 1024 + lane * 8); }
    for (int row = rfirst; row < row0 + nrows; row += rstep) {
        const u32x4 c0 = nx0, c1 = nx1, c2 = nx2;
        if (row + rstep < row0 + nrows) { const bf16_t* pr = P1 + (size_t)(row + rstep) * 1536; nx0 = *(const u32x4*)(pr + lane * 8); nx1 = *(const u32x4*)(pr + 512 + lane * 8); nx2 = *(const u32x4*)(pr + 1024 + lane * 8); }
        float x0[8], x1[8], x2[8]; unpack8(c0, x0); unpack8(c1, x1); unpack8(c2, x2);
        float s0 = 0.f, q0 = 0.f, s2 = 0.f, q2 = 0.f;
#pragma unroll
        for (int i = 0; i < 8; ++i) { s0 += x0[i]; q0 += x0[i] * x0[i]; x1[i] = gelu_f(x1[i]); x2[i] = gelu_f(x2[i]); s2 += x2[i]; q2 += x2[i] * x2[i]; }
        const float ss_cq = wave_sum(is_cq ? q0 : 0.f), ss_kv = wave_sum(is_kv ? q0 : 0.f), s_ki = wave_sum(is_ki ? s0 : 0.f), q_ki = wave_sum(is_ki ? q0 : 0.f);
        s2 = wave_sum(s2); q2 = wave_sum(q2);
        const float mean_ki = s_ki * (1.0f / 64.f), var_ki = q_ki * (1.0f / 64.f) - mean_ki * mean_ki;
        const float sc0 = is_cq ? fast_rsq(ss_cq * (1.0f / 256.f) + 1e-6f) : (is_kv ? fast_rsq(ss_kv * (1.0f / 128.f) + 1e-6f) : (is_ki ? fast_rsq(fmaxf(var_ki, 0.f) + 1e-5f) : 0.35355339059327373f));
        const float sub0 = is_ki ? mean_ki : 0.f;
#pragma unroll
        for (int i = 0; i < 8; ++i) x0[i] = (x0[i] - sub0) * sc0 * g0[i] + b0[i];
        if (is_cq) *(u32x4*)(CQN + (size_t)row * 256 + lane * 8) = pack8f(x0);
        else if (is_kv) *(u32x4*)(CKVN + (size_t)row * 128 + (lane - 32) * 8) = pack8f(x0);
        else if (is_ki) *(u32x4*)(KIDXN + (size_t)row * 64 + (lane - 48) * 8) = pack8f(x0);
        else if (is_w) { *(f32x4*)(WIDX + (size_t)row * 8) = (f32x4){x0[0], x0[1], x0[2], x0[3]}; *(f32x4*)(WIDX + (size_t)row * 8 + 4) = (f32x4){x0[4], x0[5], x0[6], x0[7]}; }
        *(u32x4*)(U + (size_t)row * 512 + lane * 8) = pack8f(x1);
        const float mean2 = s2 * (1.0f / 512.f), var2 = q2 * (1.0f / 512.f) - mean2 * mean2, rstd2 = fast_rsq(fmaxf(var2, 0.f) + 1e-5f);
#pragma unroll
        for (int i = 0; i < 8; ++i) x2[i] = (x2[i] - mean2) * rstd2 * vg[i] + vb[i];
        *(u32x4*)(DVN + (size_t)row * 512 + lane * 8) = pack8f(x2);
    }
}
__device__ NOINL void ph_hgrn(LAS unsigned char* lds, unsigned char* ws, int unit) { const Frame F = mk_frame(lds); hgrn_unit(F, ws, unit); }
__device__ NOINL void ph_hgrnA(LAS unsigned char* lds, unsigned char* ws, int unit) { const Frame F = mk_frame(lds); hgrn_passA(F, ws, unit); }
__device__ NOINL void ph_conv(LAS unsigned char* lds, unsigned char* ws, int wg, int nwg) { const Frame F = mk_frame(lds); conv_part(F, ws, wg, nwg); }
__device__ NOINL void ph_fin(LAS unsigned char* lds, unsigned char* ws) { const Frame F = mk_frame(lds); hgrn_finalize(F, ws); }
__device__ NOINL void ph_gmlp(LAS unsigned char* lds, unsigned char* ws, int panel) { const Frame F = mk_frame(lds);
    u32x4 da[4], db[4];
    if (panel >= 0) { gmlp_load(F, ws, 8 * panel, da);
        for (int k = 0; k < 8; k += 2) { gmlp_unit(F, ws, 8 * panel + k, da, db, 8 * panel + k + 1); gmlp_unit(F, ws, 8 * panel + k + 1, db, da, k + 2 < 8 ? 8 * panel + k + 2 : -1); } }
    else for (int u = blockIdx.x; u < 2048; u += F.G) { gmlp_load(F, ws, u, da); gmlp_unit(F, ws, u, da, db, -1); } }
__device__ NOINL void ph_dsa(LAS unsigned char* lds, unsigned char* ws) { const Frame F = mk_frame(lds);
    for (int tl = blockIdx.x; tl < 2048; tl += F.G) { const int b = tl & 7, idx = tl >> 3, i = idx >> 5, j = idx & 31; dsa_tile(F, ws, b, (i & 1) ? 32 * i + 31 - j : 32 * i + j); } }
__device__ NOINL void ph_final(LAS unsigned char* lds, unsigned char* ws, float* out, int slot, int row0, int nrows) { const Frame F = mk_frame(lds);
    const float* rsp = (const float*)(ws + WS_RSP) + (size_t)slot * M * 4; const float* fg = INP(I_FINAL);
    f32x4 gv[4];
#pragma unroll
    for (int j = 0; j < 4; ++j) gv[j] = *((const f32x4*)fg + F.lane + 64 * j);
    const int rstep = (nrows == M ? F.NGW : NWAVES), rfirst = row0 + (nrows == M ? F.gw : F.wave);
    f32x4 np; u32x2 nx[4];
    if (rfirst < row0 + nrows) { np = *(const f32x4*)(rsp + (size_t)rfirst * 4); const u32x2* xs = (const u32x2*)((const bf16_t*)(ws + WS_XB) + (size_t)rfirst * D) + F.lane;
#pragma unroll
        for (int j = 0; j < 4; ++j) nx[j] = xs[64 * j]; }
    for (int row = rfirst; row < row0 + nrows; row += rstep) { const f32x4 p = np; u32x2 cx4[4];
#pragma unroll
        for (int j = 0; j < 4; ++j) cx4[j] = nx[j];
        if (row + rstep < row0 + nrows) { np = *(const f32x4*)(rsp + (size_t)(row + rstep) * 4); const u32x2* xs = (const u32x2*)((const bf16_t*)(ws + WS_XB) + (size_t)(row + rstep) * D) + F.lane;
#pragma unroll
            for (int j = 0; j < 4; ++j) nx[j] = xs[64 * j]; }
        const float rs = fast_rsq(((p[0] + p[1]) + (p[2] + p[3])) * (1.0f / 1024.f) + 1e-6f);
        f32x4* xr = (f32x4*)(out + (size_t)row * D) + F.lane;
#pragma unroll
        for (int j = 0; j < 4; ++j) { const u32x2 xo = cx4[j]; xr[64 * j] = (f32x4){bflo(xo.x), bfhi(xo.x), bflo(xo.y), bfhi(xo.y)} * rs * gv[j]; } }
}

constexpr int N_PHASES = 23;

#ifndef PH_MASK
#define PH_MASK 0xffffffffu
#endif
#define EN(k) (((PH_MASK) >> (k)) & 1u)
#ifndef DUP_MASK
#define DUP_MASK 0x0u
#endif
#define DUP(k) (((DUP_MASK) >> (k)) & 1u)
__global__ void __launch_bounds__(NTHR, 2) mk_fwd(Args args) {
    extern __shared__ __attribute__((aligned(16))) unsigned char lds_raw[];
    LAS unsigned char* lds = (LAS unsigned char*)lds_raw;
#define KARG ((const volatile __attribute__((address_space(4))) Args*)__builtin_amdgcn_kernarg_segment_ptr())
#define ws ((unsigned char*)KARG->ws)
#define out ((float*)KARG->out)
    const int G = gridDim.x, bx = blockIdx.x, tid = threadIdx.x;
    volatile LAS unsigned* MISC = (volatile LAS unsigned*)(lds + MISC_OFF);
    if (tid < 64) MISC[tid] = 0u;
    if (tid < 32) *(const float* LAS*)(lds + PTAB_OFF + 8 * tid) = args.in[tid];
    __syncthreads();
#if MK_N_LAUNCHES == 1
    (void)xcd_barrier_post((unsigned*)(ws + WS_CTL) + CW_BAR, MISC + 8);
#define GRID_BAR() do { XcdBarrier b_; unsigned char* wso_ = ws; b_.bar = (unsigned*)(wso_ + WS_CTL) + CW_BAR; b_.x = xb_xcc_id(); b_.st = (volatile LAS unsigned*)(lds + MISC_OFF) + 8; xcd_barrier(b_); } while (0)
#else
#define GRID_BAR() do { } while (0)
#endif
    const int lo = (MK_N_LAUNCHES == 1) ? 0 : args.ph_lo, hi = (MK_N_LAUNCHES == 1) ? N_PHASES : args.ph_hi;
#define IN(k) (lo <= (k) && (k) < hi)
#define SEAM(k) do { if (IN(k) && IN((k) + 1)) GRID_BAR(); } while (0)
    if (EN(0) && IN(0)) { ph_prologue(lds, ws); if (DUP(0)) { GRID_BAR(); ph_prologue(lds, ws); } }
    SEAM(0);
#pragma unroll
    for (int L = 0; L < 2; ++L) {
        if (L == 0) {
            if (EN(1) && IN(1)) { const int half = G / 2; if (EN(23)) { if (bx < half) ph_gemm_bf(lds, ws, 0, half, bx, 0); else ph_gemm_bf(lds, ws, 7, G - half, bx - half, 0); } if (EN(24)) ph_gemm_in0(lds, ws); if (DUP(1)) { GRID_BAR(); ph_gemm_in0(lds, ws); } }
            SEAM(1);
            if (EN(2) && IN(2)) { for (int u = bx; u < 256; u += G) ph_hgrnA(lds, ws, u); ph_conv(lds, ws, bx, G); GRID_BAR(); for (int u = bx; u < 256; u += G) ph_hgrn(lds, ws, u); }
            SEAM(3);
            if (EN(4) && IN(4)) { { const int q4 = G / 4, hh = bx / q4, cc = bx % q4; if (hh < 4) { ph_gemm_bf(lds, ws, 8, q4, cc, hh); ph_gemm_bf(lds, ws, 9, q4, cc, hh); } }
                ph_gemm_res(lds, ws, out, (const float*)KARG->in[I_X], 0); }
            SEAM(4);
        } else {
            if (G == 256) {
                if (IN(11)) { ph_gemm_bf(lds, ws, 6, -1, bx, 0); ph_post1(lds, ws, 256 * bx, 256); WG_BAR(); ph_gemm_bf(lds, ws, 5, -1, bx, 0); ph_gmlp(lds, ws, bx); }
            } else {
            if (EN(11) && IN(11)) ph_gemm_bf(lds, ws, 6, G, bx, 0);
            SEAM(11);
            if (EN(15) && IN(12)) { ph_post1(lds, ws, 0, M); }
            SEAM(12);
            if (EN(12) && IN(13)) { if (EN(25)) ph_gemm_bf(lds, ws, 5, G, bx, 0); if (EN(22)) ph_gmlp(lds, ws, -1); }
            }
            SEAM(13);
            if (EN(13) && IN(14)) { ph_dsa(lds, ws); if (DUP(13)) { GRID_BAR(); ph_dsa(lds, ws); } }
            SEAM(14);
            if (EN(14) && IN(15)) { { const int q4 = G / 4, hh = bx / q4, cc = bx % q4; if (hh < 4) { ph_gemm_bf(lds, ws, 8, q4, cc, 4 + hh); ph_gemm_bf(lds, ws, 9, q4, cc, 4 + hh); } }
                ph_gemm_res(lds, ws, out, out, 1); }
            SEAM(15);
        }
        const int pb = L ? 16 : 5;
        if (EN(6) && IN(pb + 1)) { ph_gemm_s(lds, ws, L); if (DUP(6)) { GRID_BAR(); ph_gemm_s(lds, ws, L); } }
        SEAM(pb + 1);
        if (EN(8) && IN(pb + 3)) ph_gemm_res(lds, ws, out, out, 2 + L);
        SEAM(pb + 3);
        if (EN(9) && IN(pb + 4)) { ph_gemm_ffn1(lds, ws, L); if (DUP(9)) { GRID_BAR(); ph_gemm_ffn1(lds, ws, L); } }
        SEAM(pb + 4);
        if (EN(10) && IN(pb + 5)) ph_gemm_res(lds, ws, out, out, 4 + L);
        if (!(L == 1 && G == 256)) SEAM(pb + 5);
    }
    if (EN(21) && IN(22)) { if (G == 256) ph_final(lds, ws, out, 6, 256 * bx, 256); else ph_final(lds, ws, out, 6, 0, M); }
#undef ws
#undef out
#undef KARG
#undef IN
#undef SEAM
}

extern "C" void kernel_launch(void* const* d_in, const int* in_sizes, int n_in, void* d_out, int out_size, void* d_ws, size_t ws_size, hipStream_t stream) {
    static int grid = 0;
    if (grid == 0) {
        if (n_in != N_IN || in_sizes[0] != M * D || out_size != M * D || ws_size < WS_END) { fprintf(stderr, "kernel_launch: unexpected shapes (n_in %d, in0 %d, out %d, ws %zu)\n", n_in, n_in > 0 ? in_sizes[0] : -1, out_size, ws_size); grid = -1; return; }
        int dev = 0, cus = 0, per_cu = 0;
        if (hipGetDevice(&dev) != hipSuccess || hipDeviceGetAttribute(&cus, hipDeviceAttributeMultiprocessorCount, dev) != hipSuccess) { grid = -1; return; }
        if (hipFuncSetAttribute((const void*)mk_fwd, hipFuncAttributeMaxDynamicSharedMemorySize, LDS_BYTES) != hipSuccess) { fprintf(stderr, "kernel_launch: hipFuncSetAttribute failed\n"); grid = -1; return; }
        if (hipOccupancyMaxActiveBlocksPerMultiprocessor(&per_cu, (const void*)mk_fwd, NTHR, LDS_BYTES) != hipSuccess || per_cu < 1) fprintf(stderr, "kernel_launch: occupancy query reports %d\n", per_cu);
        (void)hipGetLastError();
        grid = cus;
        if (grid != 256) fprintf(stderr, "kernel_launch: %d CUs (built for 256)\n", grid);
    }
    if (grid < 0) return;
    if (hipMemsetAsync((char*)d_ws + WS_CTL, 0, CTL_ZERO_BYTES, stream) != hipSuccess) return;
    Args a{};
    for (int i = 0; i < N_IN; ++i) a.in[i] = (const float*)d_in[i];
    a.out = (float*)d_out; a.ws = (unsigned char*)d_ws; a.fin_slot = TRUNC_SLOT;
#if MK_N_LAUNCHES == 1
    a.ph_lo = 0; a.ph_hi = N_PHASES;
    hipLaunchKernelGGL(mk_fwd, dim3(grid), dim3(NTHR), LDS_BYTES, stream, a);
#else
    for (int p = 0; p < N_PHASES; ++p) { if (!((LAUNCH_MASK >> p) & 1u)) continue; a.ph_lo = p; a.ph_hi = p + 1; hipLaunchKernelGGL(mk_fwd, dim3(grid), dim3(NTHR), LDS_BYTES, stream, a); }
#endif
}
```

```cpp
#include <hip/hip_runtime.h>
#include <cstdio>
#include <cstdint>

#ifndef MK_N_LAUNCHES
#define MK_N_LAUNCHES 1
#endif

#ifndef LAUNCH_MASK
#define LAUNCH_MASK 0x7fffffu
#define TRUNC_SLOT 6
#define DBG_A0SRC 0
#define DBG_FIN_SRC WS_HO
#define HG_DBG 0
#endif
#ifndef DSA_DUP
#define DSA_DUP 0
#endif
#define LAS __attribute__((address_space(3)))
#define GAS __attribute__((address_space(1)))
typedef unsigned short bf16_t;
typedef short bf16x8 __attribute__((ext_vector_type(8)));
typedef short s16x4 __attribute__((ext_vector_type(4)));
typedef float f32x4 __attribute__((ext_vector_type(4)));
typedef float f32x2 __attribute__((ext_vector_type(2)));
typedef float f32x16 __attribute__((ext_vector_type(16)));
typedef unsigned u32x4 __attribute__((ext_vector_type(4)));
typedef unsigned u32x2 __attribute__((ext_vector_type(2)));
typedef GAS unsigned gu32;

constexpr int BATCH = 8, SEQ = 8192, D = 1024, M = BATCH * SEQ;
constexpr int MEMLEN = 256, MROWS = BATCH * MEMLEN;
constexpr int FF = 2816;
constexpr int NIN0 = 3584, NIN1 = 1536;
constexpr int NWAVES = 8, NTHR = 512;

constexpr size_t MiB = 1u << 20;
constexpr size_t WS_CTL = 0, CTL_ZERO_BYTES = 1 * MiB;
constexpr size_t WS_W_IN0T  = 2 * MiB;
constexpr size_t WS_W_OUT0T = WS_W_IN0T + (size_t)NIN0 * D * 2;
constexpr size_t WS_W_IN1T  = WS_W_OUT0T + (size_t)D * D * 2;
constexpr size_t WS_W_Q1T   = WS_W_IN1T + (size_t)NIN1 * D * 2;
constexpr size_t WS_W_OUT1T = WS_W_Q1T + (size_t)1536 * 256 * 2;
constexpr size_t WS_W_XQT   = WS_W_OUT1T + (size_t)D * 1536 * 2;
constexpr size_t WS_W_XKT   = WS_W_XQT + (size_t)2 * D * D * 2;
constexpr size_t WS_W_XVT   = WS_W_XKT + (size_t)2048 * D * 2;
constexpr size_t WS_W_XOT   = WS_W_XVT + (size_t)2048 * D * 2;
constexpr size_t WS_W_13T   = WS_W_XOT + (size_t)2 * D * D * 2;
constexpr size_t WS_W_2T    = WS_W_13T + (size_t)2 * 5632 * D * 2;
constexpr size_t WS_WC      = WS_W_2T + (size_t)2 * D * FF * 2;
constexpr size_t WS_LB      = WS_WC + (size_t)4 * 128 * 128 * 2;
constexpr size_t WS_MEMB    = WS_LB + 4096;
constexpr size_t WS_MEMRS   = WS_MEMB + (size_t)MROWS * D * 2;
constexpr size_t WS_KM      = WS_MEMRS + (size_t)MROWS * 4;
constexpr size_t WS_VT      = WS_KM + (size_t)MROWS * 2048 * 2;
constexpr size_t WS_RSP     = WS_VT + (size_t)2048 * MROWS * 2;
constexpr size_t WS_EBG     = WS_RSP + (size_t)7 * M * 16;
constexpr size_t WS_DVST    = WS_EBG + (size_t)(M / 64) * 512 * 4;
constexpr size_t WS_WIDX    = WS_DVST + (size_t)M * 16;
constexpr size_t WS_SLOC    = WS_WIDX + (size_t)M * 32;
constexpr size_t WS_DSEG    = WS_SLOC + (size_t)256 * 16384 * 4;
constexpr size_t WS_XB      = 124 * MiB;
constexpr size_t WS_BIG1    = 252 * MiB;
constexpr size_t WS_BIG2    = 636 * MiB;
constexpr size_t WS_WQK     = 988 * MiB;
constexpr size_t WS_VWOT    = 1004 * MiB;
constexpr size_t WS_END     = 1020 * MiB;
static_assert(WS_BIG2 + (size_t)M * FF * 2 <= WS_WQK, "ws map");
static_assert(WS_DSEG + (size_t)256 * 128 * 4 <= WS_XB, "ws map");
constexpr size_t T64 = (size_t)M * 512 * 2;
constexpr size_t WS_QE = WS_BIG1, WS_KINV = WS_BIG1 + T64, WS_KDEC = WS_BIG1 + 2 * T64, WS_HV = WS_BIG1 + 3 * T64, WS_HZ = WS_BIG1 + 4 * T64;
constexpr size_t WS_A0 = WS_BIG2, WS_HO = WS_BIG2 + 2 * T64, WS_HG = WS_BIG2 + 3 * T64, WS_HB = WS_BIG2 + 4 * T64;
constexpr size_t WS_P = WS_BIG1, WS_ACT = WS_BIG2;
constexpr size_t WS_CQN = WS_BIG1, WS_CKVN = WS_CQN + (size_t)M * 256 * 2, WS_KIDXN = WS_CKVN + (size_t)M * 128 * 2, WS_U = WS_KIDXN + (size_t)M * 64 * 2,
                 WS_DV = WS_U + T64, WS_QL = WS_DV + T64, WS_QI = WS_QL + 2 * T64, WS_A1 = WS_BIG2, WS_P1RAW = WS_BIG2;
static_assert(WS_QI + T64 <= WS_BIG2, "ws map");
constexpr size_t WS_SCR = WS_BIG2 + 192 * MiB;
static_assert(WS_SCR + (size_t)256 * 524288 <= WS_BIG2 + 384 * MiB, "ws map");

constexpr int CW_TMO = 0;
constexpr int CW_BAR = 4096;

constexpr int RING_BYTES = 131072;
constexpr int XLDS_OFF = RING_BYTES;
constexpr int MISC_OFF = 159744 - 256;
constexpr int PTAB_OFF = 159744 - 512;
constexpr int LDS_BYTES = 159744;

#define RLX_AGENT __ATOMIC_RELAXED, __HIP_MEMORY_SCOPE_AGENT
#define LDS_WAIT() asm volatile("s_waitcnt lgkmcnt(0)" ::: "memory")
#define VM_WAIT() asm volatile("s_waitcnt vmcnt(0)" ::: "memory")
#define WG_BAR() do { asm volatile("s_waitcnt vmcnt(0) lgkmcnt(0)" ::: "memory"); __builtin_amdgcn_s_barrier(); asm volatile("" ::: "memory"); } while (0)
#define LDS_BAR() do { asm volatile("s_waitcnt lgkmcnt(0)" ::: "memory"); __builtin_amdgcn_s_barrier(); asm volatile("" ::: "memory"); } while (0)

typedef __bf16 bf16x2_t __attribute__((ext_vector_type(2)));
__device__ __forceinline__ unsigned cvt_pk_bf16(float lo, float hi) { const f32x2 v = {lo, hi}; return __builtin_bit_cast(unsigned, __builtin_convertvector(v, bf16x2_t)); }
__device__ __forceinline__ u32x2 pack4(f32x4 v) { u32x2 w; w.x = cvt_pk_bf16(v[0], v[1]); w.y = cvt_pk_bf16(v[2], v[3]); return w; }
__device__ __forceinline__ u32x4 pack8(f32x4 a, f32x4 b) { u32x4 w; w.x = cvt_pk_bf16(a[0], a[1]); w.y = cvt_pk_bf16(a[2], a[3]); w.z = cvt_pk_bf16(b[0], b[1]); w.w = cvt_pk_bf16(b[2], b[3]); return w; }
__device__ __forceinline__ float bf2f(unsigned short b) { return __uint_as_float(((unsigned)b) << 16); }
__device__ __forceinline__ float bflo(unsigned w) { return __uint_as_float(w << 16); }
__device__ __forceinline__ float bfhi(unsigned w) { return __uint_as_float(w & 0xffff0000u); }
__device__ __forceinline__ float fast_exp2(float x) { return __builtin_amdgcn_exp2f(x); }
__device__ __forceinline__ float fast_rcp(float x) { return __builtin_amdgcn_rcpf(x); }
__device__ __forceinline__ float fast_rsq(float x) { return __builtin_amdgcn_rsqf(x); }
__device__ __forceinline__ float sigmoid_f(float x) { return fast_rcp(1.0f + fast_exp2(-1.4426950408889634f * x)); }
__device__ __forceinline__ float silu_f(float x) { return x * sigmoid_f(x); }
__device__ __forceinline__ float gelu_f(float v) {
    const float av = __builtin_fabsf(v), t = fast_rcp(av * 0.2316418882f + 1.0f);
    float q = t * 0.5307027145f + (-0.7265760135f); q = q * t + 0.7107068705f; q = q * t + (-0.142248368f); q = q * t + 0.127414796f; q = q * t;
    const float e = fast_exp2((v * v) * (-0.72134752044f));
    const float m = v * (q * e);
    return v < 0.f ? m : v - m;
}
__device__ __forceinline__ int opq(int v) { asm volatile("" : "+v"(v)); return v; }
__device__ __forceinline__ int opq_s(int v) { asm volatile("" : "+s"(v)); return v; }
__device__ __forceinline__ float wave_sum(float v) {
    v += __builtin_bit_cast(float, __builtin_amdgcn_update_dpp(0, __builtin_bit_cast(int, v), 0x111, 0xf, 0xf, true));
    v += __builtin_bit_cast(float, __builtin_amdgcn_update_dpp(0, __builtin_bit_cast(int, v), 0x112, 0xf, 0xf, true));
    v += __builtin_bit_cast(float, __builtin_amdgcn_update_dpp(0, __builtin_bit_cast(int, v), 0x114, 0xf, 0xf, true));
    v += __builtin_bit_cast(float, __builtin_amdgcn_update_dpp(0, __builtin_bit_cast(int, v), 0x118, 0xf, 0xf, true));
    v += __builtin_bit_cast(float, __builtin_amdgcn_update_dpp(0, __builtin_bit_cast(int, v), 0x142, 0xa, 0xf, false));
    v += __builtin_bit_cast(float, __builtin_amdgcn_update_dpp(0, __builtin_bit_cast(int, v), 0x143, 0xc, 0xf, false));
    return __builtin_bit_cast(float, __builtin_amdgcn_readlane(__builtin_bit_cast(int, v), 63));
}

#define XB_TMO      128
#define XB_XCNT(j)  (256  + 64 * (j))
#define XB_XSUB(j)  (1280 + 64 * (j))
#define XB_XGEN(j)  (2304 + 64 * (j))
#define XB_TOP      3328
#define XB_TOPGEN   3392
#define XCD_BAR_WORDS 3456
#define XB_SPIN_CAP (1u << 22)

__device__ __forceinline__ unsigned xb_ld(unsigned* p)              { return __hip_atomic_load(p, __ATOMIC_RELAXED, __HIP_MEMORY_SCOPE_AGENT); }
__device__ __forceinline__ unsigned xb_add(unsigned* p, unsigned v) { return __hip_atomic_fetch_add(p, v, __ATOMIC_RELAXED, __HIP_MEMORY_SCOPE_AGENT); }
__device__ __forceinline__ unsigned xb_xcc_id() { return (unsigned)__builtin_amdgcn_s_getreg((3 << 11) | 20) & 0xFu; }
#define XB_SPIN(cond, bar) do { unsigned _sp = 0; while (cond) { __builtin_amdgcn_s_sleep(1); \
    if ((++_sp & 255u) == 0u) { if (xb_ld(&(bar)[XB_TMO])) break; if (_sp > XB_SPIN_CAP) { atomicAdd(&(bar)[XB_TMO], 1u); break; } } } } while (0)

struct XcdBarrier { unsigned* bar; unsigned x; volatile LAS unsigned* st; };
__device__ __forceinline__ XcdBarrier xcd_barrier_post(unsigned* bar, volatile LAS unsigned* st) {
    XcdBarrier b; b.bar = bar; b.x = xb_xcc_id(); b.st = st;
    if (threadIdx.x == 0) (void)xb_add(&bar[XB_XCNT(b.x)], 1u);
    return b;
}
__device__ __forceinline__ void xcd_barrier_complete(unsigned* bar, unsigned x, unsigned& nloc, unsigned& nx) {
    const unsigned G = gridDim.x * gridDim.y * gridDim.z;
    unsigned sum, cnt, mine, sp = 0u;
    for (;;) {
        sum = 0u; cnt = 0u; mine = 0u;
#pragma unroll
        for (unsigned j = 0; j < 16; ++j) { const unsigned c = xb_ld(&bar[XB_XCNT(j)]); sum += c; cnt += (c > 0u) ? 1u : 0u; mine = (j == x) ? c : mine; }
        if (sum == G) break;
        __builtin_amdgcn_s_sleep(1);
        if ((++sp & 255u) == 0u) { if (xb_ld(&bar[XB_TMO])) break; if (sp > XB_SPIN_CAP) { atomicAdd(&bar[XB_TMO], 1u); break; } }
    }
    nloc = mine > 0u ? mine : 1u; nx = cnt > 0u ? cnt : 1u;
}
__device__ __forceinline__ void xcd_barrier(const XcdBarrier& b) {
    asm volatile("s_waitcnt vmcnt(0)" ::: "memory");
    __syncthreads();
    if (threadIdx.x == 0) {
        unsigned* bar = b.bar;
        __builtin_amdgcn_s_waitcnt(0);
        unsigned nloc = b.st[0], nx = b.st[1];
        if (nloc == 0u) { xcd_barrier_complete(bar, b.x, nloc, nx); b.st[0] = nloc; b.st[1] = nx; }
        const unsigned old = xb_add(&bar[XB_XSUB(b.x)], 1u);
        const unsigned gen = old / nloc;
        if (old + 1u == (gen + 1u) * nloc) {
            __builtin_amdgcn_fence(__ATOMIC_RELEASE, "agent");
            asm volatile("s_waitcnt vmcnt(0)" ::: "memory");
            const unsigned og = xb_add(&bar[XB_TOP], 1u);
            const unsigned tg = og / nx;
            if (og + 1u == (tg + 1u) * nx) xb_add(&bar[XB_TOPGEN], 1u);
            else XB_SPIN(xb_ld(&bar[XB_TOPGEN]) == tg, bar);
            __builtin_amdgcn_fence(__ATOMIC_ACQUIRE, "agent");
            xb_add(&bar[XB_XGEN(b.x)], 1u);
            asm volatile("s_waitcnt vmcnt(0)" ::: "memory");
        } else {
            XB_SPIN(xb_ld(&bar[XB_XGEN(b.x)]) == gen, bar);
            __builtin_amdgcn_fence(__ATOMIC_ACQUIRE, "agent");
            asm volatile("s_waitcnt vmcnt(0)" ::: "memory");
        }
    }
    __syncthreads();
}

namespace pg8 {
constexpr int BM = 256, BK = 64, HALF = 128, HTB = HALF * BK * 2, NXCD = 8, WGM = 8;
__host__ __device__ __forceinline__ int lds_byte(int r, int c) { const int st = (r >> 4) * 2 + (c >> 5), rr = r & 15, cc = c & 31, ob = rr * 64 + cc * 2; return st * 1024 + (ob ^ (((ob >> 9) & 1) << 5)); }
__host__ __device__ __forceinline__ void stage_rc(int b, int& R, int& C) { const int st = b / 1024, sb = b % 1024, swz = sb ^ (((sb >> 9) & 1) << 5); R = (st >> 1) * 16 + swz / 64; C = (st & 1) * 32 + (swz % 64) / 2; }
__host__ __device__ __forceinline__ int perm32(int rho) { const int n = rho >> 4, i = rho & 15; return 8 * (i >> 2) + 4 * n + (i & 3); }
struct Unit { int pm, pn; };
struct Gemm { const bf16_t* A; const bf16_t* Bt; int lda, ldb, K; size_t a_pm, a_pn, b_pn, b_pm; int b_sh; };
__device__ __forceinline__ Gemm plain_gemm(const bf16_t* A, const bf16_t* Bt, int K) { Gemm g; g.A = A; g.Bt = Bt; g.lda = K; g.ldb = K; g.K = K; g.a_pm = (size_t)256 * K * 2; g.a_pn = 0; g.b_pn = (size_t)256 * K * 2; g.b_pm = 0; g.b_sh = 0; return g; }
struct StaticOrder {
    int nM, nN, nwg, G, c;
    __device__ void init(int nM_, int nN_, int G_, int c_) { nM = nM_; nN = nN_; nwg = nM * nN; G = G_; c = c_; }
    __device__ void init_panel(int nN_, int pm_) { nM = 1; nN = nN_; nwg = nN_; G = -1; c = pm_; }
    __device__ bool next(int i, Unit& u) const {
        if (G < 0) { if (i >= nN) return false; u.pm = c; u.pn = (i + (c >> 3)) % nN; return true; }
        const long L = (long)i * G + c; if (L >= nwg) return false;
        int wgid = (int)L; { const int q = nwg / NXCD, r = nwg % NXCD, xcd = wgid % NXCD, off = wgid / NXCD; wgid = (xcd < r ? xcd * (q + 1) : r * (q + 1) + (xcd - r) * q) + off; }
        const int nig = WGM * nN, gid = wgid / nig, fm = gid * WGM, gsz = (nM - fm) < WGM ? (nM - fm) : WGM;
        u.pm = fm + ((wgid % nig) % gsz); u.pn = (wgid % nig) / gsz; return true;
    }
};
struct EpiCtx { int wr, wc, fr, fq, wid, lane; LAS unsigned char* xl; };

template <class Epi>
__device__ __forceinline__ void gemm_phase(LAS unsigned char* lds, const Gemm g, const StaticOrder& S, const Epi& E) {
    int tid_ = threadIdx.x; asm volatile("" : "+v"(tid_));
    const int tid = tid_, wid = __builtin_amdgcn_readfirstlane(tid >> 6), lane = tid & 63, wr = wid >> 2, wc = wid & 3, fr = lane & 15, fq = lane >> 4;
    const int K = g.K, nt = K / BK;
    unsigned voffA[2], voffB[2];
#pragma unroll
    for (int i = 0; i < 2; ++i) { int R, C; stage_rc(tid * 16 + i * 8192, R, C); const int Rb = Epi::PERM ? ((R & ~31) + perm32(R & 31)) : R;
        voffA[i] = (unsigned)(R * g.lda + C) * 2u; voffB[i] = (unsigned)(Rb * g.ldb + C) * 2u; }
    const size_t kstep = (size_t)(BK * 2);
    const size_t hstepA = (size_t)HALF * g.lda * 2, hstepB = (size_t)HALF * g.ldb * 2;
    const unsigned ldsw = (unsigned)wid * 1024u;
    const int aoff = lds_byte(wr * 64 + fr, fq * 8), boff = lds_byte(wc * 32 + fr, fq * 8);
    EpiCtx cx; cx.wr = wr; cx.wc = wc; cx.fr = fr; cx.fq = fq; cx.wid = wid; cx.lane = lane; cx.xl = lds + XLDS_OFF;
#define PG8_SA(b, h) (((b) * 2 + (h)) * HTB)
#define PG8_SB(b, h) ((4 + (b) * 2 + (h)) * HTB)
#define PG8_STAGE(bufoff, gbase, voff) do { _Pragma("unroll") for (int _i = 0; _i < 2; ++_i) \
        __builtin_amdgcn_global_load_lds((const unsigned*)((const char*)(gbase) + (voff)[_i]), (LAS unsigned*)(lds + (bufoff) + ldsw + _i * 8192), 16, 0, 0); } while (0)
#define PG8_LDA(dst, b, h) do { _Pragma("unroll") for (int m = 0; m < 4; ++m) _Pragma("unroll") for (int k = 0; k < 2; ++k) dst[m][k] = *(const LAS bf16x8*)(lds + PG8_SA(b, h) + aoff + m * 2048 + k * 1024); } while (0)
#define PG8_LDB(dst, b, h) do { _Pragma("unroll") for (int n = 0; n < 2; ++n) _Pragma("unroll") for (int k = 0; k < 2; ++k) dst[n][k] = *(const LAS bf16x8*)(lds + PG8_SB(b, h) + boff + n * 2048 + k * 1024); } while (0)
#define PG8_MMA(ai, bj, At, Bt) do { __builtin_amdgcn_s_setprio(1); _Pragma("unroll") for (int m = 0; m < 4; ++m) _Pragma("unroll") for (int n = 0; n < 2; ++n) _Pragma("unroll") for (int k = 0; k < 2; ++k) \
        acc[ai][bj][m][n] = __builtin_amdgcn_mfma_f32_16x16x32_bf16(Bt[n][k], At[m][k], acc[ai][bj][m][n], 0, 0, 0); __builtin_amdgcn_s_setprio(0); } while (0)
#define PG8_WAIT_V(n) asm volatile("s_waitcnt vmcnt(" #n ")" ::: "memory")
#define PG8_WAIT_L(n) asm volatile("s_waitcnt lgkmcnt(" #n ")" ::: "memory")
#define PG8_BAR __builtin_amdgcn_s_barrier()
#define PG8_SCHED __builtin_amdgcn_sched_barrier(0)
    Unit cur, nxt; int ui = 0;
    if (!S.next(0, cur)) return;
    f32x4 acc[2][2][4][2];
#pragma unroll
    for (int a = 0; a < 2; ++a)
#pragma unroll
        for (int b = 0; b < 2; ++b)
#pragma unroll
            for (int m = 0; m < 4; ++m)
#pragma unroll
                for (int n = 0; n < 2; ++n) acc[a][b][m][n] = (f32x4){0.f, 0.f, 0.f, 0.f};
    bf16x8 At[4][2], B0[2][2], B1[2][2];
    const char* cA = (const char*)g.A + (size_t)cur.pm * g.a_pm + (size_t)cur.pn * g.a_pn;
    const char* cB = (const char*)g.Bt + (size_t)cur.pn * g.b_pn + (size_t)(cur.pm >> g.b_sh) * g.b_pm;
    PG8_STAGE(PG8_SB(0, 0), cB, voffB); PG8_STAGE(PG8_SB(0, 1), cB + hstepB, voffB); PG8_STAGE(PG8_SA(0, 0), cA, voffA); PG8_STAGE(PG8_SA(0, 1), cA + hstepA, voffA);
    if (wr == 1) PG8_BAR;
    PG8_WAIT_V(2); PG8_BAR;
    PG8_STAGE(PG8_SB(1, 0), cB + kstep, voffB); PG8_STAGE(PG8_SA(1, 0), cA + kstep, voffA); PG8_STAGE(PG8_SB(1, 1), cB + hstepB + kstep, voffB);
    PG8_WAIT_V(6); PG8_BAR;
    for (;;) {
        if constexpr (Epi::RSPRE) {
            if (wid < 4) __builtin_amdgcn_global_load_lds((const unsigned*)((const char*)E.rs_src() + (size_t)cur.pm * 4096 + (unsigned)(tid << 4)), (LAS unsigned*)(lds + XLDS_OFF + 12288 + wid * 1024), 16, 0, 0); }
        const bool has_next = S.next(ui + 1, nxt);
        const char* nA = has_next ? (const char*)g.A + (size_t)nxt.pm * g.a_pm + (size_t)nxt.pn * g.a_pn : cA;
        const char* nB = has_next ? (const char*)g.Bt + (size_t)nxt.pn * g.b_pn + (size_t)(nxt.pm >> g.b_sh) * g.b_pm : cB;
        for (int t = 0; t < nt; t += 2) {
            const bool last = (t == nt - 2);
            const char* a1 = cA + (size_t)(t + 1) * kstep;
            const char* a2 = last ? nA : cA + (size_t)(t + 2) * kstep; const char* b2 = last ? nB : cB + (size_t)(t + 2) * kstep;
            const char* a3 = a2 + kstep; const char* b3 = b2 + kstep;
            PG8_LDB(B0, 0, 0); PG8_LDB(B1, 0, 1); PG8_SCHED; PG8_LDA(At, 0, 0); PG8_STAGE(PG8_SA(1, 1), a1 + hstepA, voffA);
            PG8_WAIT_V(8); PG8_WAIT_L(0); PG8_BAR; PG8_MMA(0, 0, At, B0); PG8_MMA(0, 1, At, B1); PG8_BAR; PG8_SCHED;
            PG8_LDA(At, 0, 1); PG8_STAGE(PG8_SB(0, 0), b2, voffB); PG8_STAGE(PG8_SB(0, 1), b2 + hstepB, voffB); PG8_STAGE(PG8_SA(0, 0), a2, voffA);
            PG8_WAIT_V(8); PG8_WAIT_L(0); PG8_BAR; PG8_MMA(1, 0, At, B0); PG8_MMA(1, 1, At, B1); PG8_BAR; PG8_SCHED;
            PG8_LDB(B0, 1, 0); PG8_LDB(B1, 1, 1); PG8_SCHED; PG8_LDA(At, 1, 0); PG8_STAGE(PG8_SA(0, 1), a2 + hstepA, voffA);
            PG8_WAIT_V(8); PG8_WAIT_L(0); PG8_BAR; PG8_MMA(0, 0, At, B0); PG8_MMA(0, 1, At, B1); PG8_BAR; PG8_SCHED;
            PG8_LDA(At, 1, 1); PG8_STAGE(PG8_SB(1, 0), b3, voffB); PG8_STAGE(PG8_SB(1, 1), b3 + hstepB, voffB); PG8_STAGE(PG8_SA(1, 0), a3, voffA);
            PG8_WAIT_V(8); PG8_WAIT_L(0); PG8_BAR; PG8_MMA(1, 0, At, B0); PG8_MMA(1, 1, At, B1); PG8_BAR; PG8_SCHED;
        }
        if (wr == 0) PG8_BAR;
        { EpiCtx cy = cx; asm volatile("" : "+v"(cy.fr), "+v"(cy.fq), "+v"(cy.lane));
          E(acc, cur, cy); }
        if (!has_next) break;
#pragma unroll
        for (int a = 0; a < 2; ++a)
#pragma unroll
            for (int b = 0; b < 2; ++b)
#pragma unroll
                for (int m = 0; m < 4; ++m)
#pragma unroll
                    for (int n = 0; n < 2; ++n) acc[a][b][m][n] = (f32x4){0.f, 0.f, 0.f, 0.f};
        cur = nxt; cA = nA; cB = nB; ++ui;
        if (wr == 1) PG8_BAR;
    }
    PG8_WAIT_V(0);
    PG8_BAR;
#undef PG8_SA
#undef PG8_SB
#undef PG8_STAGE
#undef PG8_LDA
#undef PG8_LDB
#undef PG8_MMA
#undef PG8_WAIT_V
#undef PG8_WAIT_L
#undef PG8_BAR
#undef PG8_SCHED
}
}
using pg8::Unit; using pg8::EpiCtx;
typedef f32x4 (&AccRef)[2][2][4][2];

__device__ __forceinline__ void load_rs(const float* rsp, const Unit& u, const EpiCtx& cx, float inv_n, float eps, float (&rs)[2][4]) {
#pragma unroll
    for (int ai = 0; ai < 2; ++ai)
#pragma unroll
        for (int m = 0; m < 4; ++m) { const int row = u.pm * 256 + ai * 128 + cx.wr * 64 + m * 16 + cx.fr; const f32x4 p = *(const f32x4*)(rsp + (size_t)row * 4);
            rs[ai][m] = fast_rsq(((p[0] + p[1]) + (p[2] + p[3])) * inv_n + eps); }
}
__device__ __forceinline__ void load_rs_lds(const EpiCtx& cx, float inv_n, float eps, float (&rs)[2][4]) {
#pragma unroll
    for (int ai = 0; ai < 2; ++ai)
#pragma unroll
        for (int m = 0; m < 4; ++m) { const int rl = ai * 128 + cx.wr * 64 + m * 16 + cx.fr; const f32x4 p = *(const LAS f32x4*)(cx.xl + 12288 + rl * 16);
            rs[ai][m] = fast_rsq(((p[0] + p[1]) + (p[2] + p[3])) * inv_n + eps); }
}
__device__ __forceinline__ void row_swap16(float v, float& a, float& b) { const unsigned u = __builtin_bit_cast(unsigned, v); const auto r = __builtin_amdgcn_permlane16_swap(u, u, false, false);
    const unsigned r0 = r[0], r1 = r[1]; a = __builtin_bit_cast(float, r0); b = __builtin_bit_cast(float, r1); }
__device__ __forceinline__ void row_swap32(float v, float& a, float& b) { const unsigned u = __builtin_bit_cast(unsigned, v); const auto r = __builtin_amdgcn_permlane32_swap(u, u, false, false);
    const unsigned r0 = r[0], r1 = r[1]; a = __builtin_bit_cast(float, r0); b = __builtin_bit_cast(float, r1); }
__device__ __forceinline__ float red_fq(float v) { float a, b; row_swap16(v, a, b); v = a + b; row_swap32(v, a, b); return a + b; }
__device__ __forceinline__ float max_fq(float v) { float a, b; row_swap16(v, a, b); v = fmaxf(a, b); row_swap32(v, a, b); return fmaxf(a, b); }

enum InIdx { I_X = 0, I_MEM, I_HLB, I_EMN, I_EWIN, I_EAON, I_EBCONV, I_EWOUT, I_OMN, I_OWIN, I_OCQN, I_OCKVN, I_OWUQ, I_OWUK, I_OWUV, I_OIDXWQ, I_OIDXKG, I_OIDXKB,
             I_ODVG, I_ODVB, I_ODWS, I_ODBS, I_OWOUT, I_XAN, I_XAMN, I_XAWQ, I_XAWKV, I_XAWO, I_FFN, I_FFW13, I_FFW2, I_FINAL, N_IN };
struct Args { const float* in[32]; float* out; unsigned char* ws; int ph_lo, ph_hi, fin_slot, pad; };
struct Frame { LAS unsigned char* lds; int tid, lane, wave, G, gw, NGW; };
#define INP(i) (*(const float* const LAS*)(F.lds + PTAB_OFF + 8 * (i)))

__device__ __forceinline__ void tr_item(const float* W, int ldw, int k0, int s0, int nvalid, bf16_t* WT, int ldwt, int n0, int kout0, const float* gain, float scale, LAS float* scr, int lane) {
    const int r8 = lane >> 3, j4 = 4 * (lane & 7); f32x4 v[8];
#pragma unroll
    for (int i = 0; i < 8; ++i) { const int kk = 8 * i + r8; v[i] = (j4 < nvalid) ? __builtin_nontemporal_load((const f32x4*)(W + (size_t)(k0 + kk) * ldw + s0 + j4)) : (f32x4){0.f, 0.f, 0.f, 0.f}; }
    const int c = lane & 7; f32x4 g0 = (f32x4){1.f, 1.f, 1.f, 1.f}, g1 = g0;
    if (gain) { g0 = *(const f32x4*)(gain + k0 + 8 * c); g1 = *(const f32x4*)(gain + k0 + 8 * c + 4); }
#pragma unroll
    for (int i = 0; i < 8; ++i) { const int kk = 8 * i + r8;
#pragma unroll
        for (int e = 0; e < 4; ++e) scr[kk * 33 + j4 + e] = v[i][e]; }
    LDS_WAIT(); asm volatile("" ::: "memory");
    g0 = g0 * scale; g1 = g1 * scale;
#pragma unroll
    for (int jj = 0; jj < 4; ++jj) { const int n = (lane >> 3) + 8 * jj; const LAS float* s = scr + (8 * c) * 33 + n;
        u32x4 o; o.x = cvt_pk_bf16(s[0 * 33] * g0[0], s[1 * 33] * g0[1]); o.y = cvt_pk_bf16(s[2 * 33] * g0[2], s[3 * 33] * g0[3]); o.z = cvt_pk_bf16(s[4 * 33] * g1[0], s[5 * 33] * g1[1]); o.w = cvt_pk_bf16(s[6 * 33] * g1[2], s[7 * 33] * g1[3]);
        *(u32x4*)(WT + (size_t)(n0 + n) * ldwt + kout0 + k0 + 8 * c) = o; }
    LDS_WAIT(); asm volatile("" ::: "memory");
}
__device__ __forceinline__ int in0_src_col(int n) { const int pn = n >> 8, j = n & 255;
    if (pn < 4) return j < 128 ? pn * 128 + j : 512 + pn * 128 + (j - 128);
    if (pn < 10) return 1024 + (pn - 4) * 256 + j;
    const int q = pn - 10; return j < 128 ? 2560 + q * 128 + j : 3072 + q * 128 + (j - 128); }

__device__ __forceinline__ void p0_prologue(const Frame& F, unsigned char* ws) {
    LAS float* scr = (LAS float*)(F.lds + F.wave * 16384);
    constexpr int NJ = 17;
    const int jitems[NJ] = {1792, 512, 768, 64, 256, 0, 0, 512, 512, 512, 512, 512, 512, 2816, 2816, 1408, 1408};
    int total = 0;
#pragma unroll
    for (int j = 0; j < NJ; ++j) total += jitems[j];
    for (int it = F.gw; it < total; it += F.NGW) {
        int r = it, job = 0;
#pragma unroll
        for (int j = 0; j < NJ - 1; ++j) { if (job == j && r >= jitems[j]) { r -= jitems[j]; job = j + 1; } }
        const float* W; int ldw, K, Nout, ldwt, kout0 = 0; bf16_t* WT; const float* gain = nullptr; float scale = 1.f;
        switch (job) {
        case 0: W = INP(I_EWIN); ldw = NIN0; K = 1024; Nout = NIN0; WT = (bf16_t*)(ws + WS_W_IN0T); ldwt = 1024; gain = INP(I_EMN); break;
        case 1: W = INP(I_EWOUT); ldw = 1024; K = 1024; Nout = 1024; WT = (bf16_t*)(ws + WS_W_OUT0T); ldwt = 1024; break;
        case 2: W = INP(I_OWIN); ldw = 1480; K = 1024; Nout = 1536; WT = (bf16_t*)(ws + WS_W_IN1T); ldwt = 1024; gain = INP(I_OMN); break;
        case 3: W = INP(I_OIDXWQ); ldw = 512; K = 256; Nout = 512; WT = (bf16_t*)(ws + WS_W_Q1T) + (size_t)1024 * 256; ldwt = 256; gain = INP(I_OCQN); scale = 0.125f; break;
        case 4: W = INP(I_OWOUT) + (size_t)512 * 1024; ldw = 1024; K = 512; Nout = 1024; WT = (bf16_t*)(ws + WS_W_OUT1T); ldwt = 1536; kout0 = 1024; break;
        case 5: case 6: { const int L = job - 5; W = INP(I_XAWQ) + (size_t)L * D * D; ldw = 1024; K = 1024; Nout = 1024; WT = (bf16_t*)(ws + WS_W_XQT) + (size_t)L * D * D; ldwt = 1024; gain = INP(I_XAN) + L * D; } break;
        case 7: case 8: { const int L = job - 7; W = INP(I_XAWKV) + (size_t)L * D * 2048; ldw = 2048; K = 1024; Nout = 1024; WT = (bf16_t*)(ws + WS_W_XKT) + (size_t)L * D * D; ldwt = 1024; gain = INP(I_XAMN) + L * D; } break;
        case 9: case 10: { const int L = job - 9; W = INP(I_XAWKV) + (size_t)L * D * 2048 + 1024; ldw = 2048; K = 1024; Nout = 1024; WT = (bf16_t*)(ws + WS_W_XVT) + (size_t)L * D * D; ldwt = 1024; gain = INP(I_XAMN) + L * D; } break;
        case 11: case 12: { const int L = job - 11; W = INP(I_XAWO) + (size_t)L * D * D; ldw = 1024; K = 1024; Nout = 1024; WT = (bf16_t*)(ws + WS_W_XOT) + (size_t)L * D * D; ldwt = 1024; } break;
        case 13: case 14: { const int L = job - 13; W = INP(I_FFW13) + (size_t)L * D * 5632; ldw = 5632; K = 1024; Nout = 5632; WT = (bf16_t*)(ws + WS_W_13T) + (size_t)L * 5632 * D; ldwt = 1024; gain = INP(I_FFN) + L * D; } break;
        default: { const int L = job - 15; W = INP(I_FFW2) + (size_t)L * FF * D; ldw = 1024; K = FF; Nout = 1024; WT = (bf16_t*)(ws + WS_W_2T) + (size_t)L * D * FF; ldwt = FF; } break;
        }
        const int nblk = Nout / 32, kb = r / nblk, nb = r % nblk, n0 = nb * 32; int s0 = n0, nvalid = 32;
        if (job == 0) s0 = in0_src_col(n0);
        else if (job == 2) { if (n0 < 448) s0 = n0; else if (n0 == 448) { s0 = 448; nvalid = 8; } else if (n0 < 512) { s0 = 0; nvalid = 0; } else s0 = n0 - 56; }
        else if (job == 13 || job == 14) { const int pn = n0 >> 8, j = n0 & 255; s0 = j < 128 ? pn * 128 + j : 2816 + pn * 128 + (j - 128); }
        tr_item(W, ldw, kb * 64, s0, nvalid, WT, ldwt, n0, kout0, gain, scale, scr, F.lane);
    }
    const int gt = F.gw * 64 + F.lane, NGT = F.NGW * 64;
    { const float* wuq = INP(I_OWUQ); const float* wuk = INP(I_OWUK); const float* g = INP(I_OCQN); bf16_t* WT = (bf16_t*)(ws + WS_W_Q1T);
      for (int o = gt; o < 1024 * 256; o += NGT) { const int n = o & 1023, r = o >> 10, h = n >> 7, c = n & 127; float s = 0.f;
          for (int d = 0; d < 64; ++d) s += wuq[(size_t)r * 512 + h * 64 + d] * wuk[(size_t)(h * 64 + d) * 128 + c];
          WT[(size_t)n * 256 + r] = (bf16_t)(cvt_pk_bf16(s * 0.125f * g[r], 0.f) & 0xffffu); } }
    { const float* wuv = INP(I_OWUV); const float* wo = INP(I_OWOUT); bf16_t* WT = (bf16_t*)(ws + WS_W_OUT1T);
      for (int o = gt; o < 1024 * 1024; o += NGT) { const int n = o & 1023, k = o >> 10, h = k >> 7; float s = 0.f;
          for (int d = 0; d < 64; ++d) s += wuv[(size_t)k * 64 + d] * wo[(size_t)(h * 64 + d) * 1024 + n];
          WT[(size_t)n * 1536 + k] = (bf16_t)(cvt_pk_bf16(s, 0.f) & 0xffffu); } }
    { const float* wq = INP(I_XAWQ); const float* g = INP(I_XAN); bf16_t* WN = (bf16_t*)(ws + WS_W_XQT);
      for (int o = gt; o < 2 * D * D / 4; o += NGT) { const f32x4 v = *((const f32x4*)wq + o); const float gg = g[(o * 4) >> 10]; *((u32x2*)WN + o) = pack4(v * gg); } }
    { const float* wsrc = INP(I_ODWS); bf16_t* WC = (bf16_t*)(ws + WS_WC);
      for (int o = gt; o < 4 * 128 * 128; o += NGT) { const int s = o & 127, t = (o >> 7) & 127; WC[o] = (bf16_t)(cvt_pk_bf16(s <= t ? wsrc[o] : 0.f, 0.f) & 0xffffu); }
      const float* hl = INP(I_HLB); float* lb = (float*)(ws + WS_LB);
      for (int o = gt; o < 512; o += NGT) { const float x0 = hl[o], x1 = hl[512 + o], x2 = hl[1024 + o], mx = fmaxf(x0, fmaxf(x1, x2));
          const float e0 = __expf(x0 - mx), e1 = __expf(x1 - mx), e2 = __expf(x2 - mx); lb[o] = e0 / (e0 + e1 + e2); } }
    { const float* x = INP(I_X); bf16_t* XB = (bf16_t*)(ws + WS_XB); float* rsp = (float*)(ws + WS_RSP);
      for (int m = F.gw; m < M + MROWS; m += F.NGW) {
          const bool is_mem = m >= M; const int row = is_mem ? m - M : m;
          const float* src = is_mem ? INP(I_MEM) + (size_t)row * D : x + (size_t)row * D; bf16_t* dst = is_mem ? (bf16_t*)(ws + WS_MEMB) + (size_t)row * D : XB + (size_t)row * D;
          const f32x4* xr = (const f32x4*)src + F.lane; f32x4 v[4]; float s = 0.f;
#pragma unroll
          for (int j = 0; j < 4; ++j) { v[j] = __builtin_nontemporal_load(xr + 64 * j); s += (v[j].x * v[j].x + v[j].y * v[j].y) + (v[j].z * v[j].z + v[j].w * v[j].w); }
          s = wave_sum(s);
          u32x2* o8 = (u32x2*)dst + F.lane;
#pragma unroll
          for (int j = 0; j < 4; ++j) { u32x2 w; w.x = cvt_pk_bf16(v[j].x, v[j].y); w.y = cvt_pk_bf16(v[j].z, v[j].w); o8[64 * j] = w; }
          if (F.lane == 0) { if (is_mem) ((float*)(ws + WS_MEMRS))[row] = fast_rsq(s * (1.0f / D) + 1e-6f); else *(f32x4*)(rsp + (size_t)row * 4) = (f32x4){s, 0.f, 0.f, 0.f}; }
      } }
}


struct EpiRes { static constexpr bool PERM = true; static constexpr bool RSPRE = false;
    bf16_t* xb; float* rsp_out;
    __device__ __forceinline__ void operator()(AccRef acc, const Unit& u, const EpiCtx& cx) const {
        LAS float* T = (LAS float*)cx.xl;
        const int col0 = u.pn * 256 + cx.wc * 32 + 8 * cx.fq;
#pragma unroll
        for (int ai = 0; ai < 2; ++ai) {
            u32x4 xo[4][2];
#pragma unroll
            for (int m = 0; m < 4; ++m)
#pragma unroll
                for (int bj = 0; bj < 2; ++bj) xo[m][bj] = *(const u32x4*)(xb + (size_t)(u.pm * 256 + ai * 128 + cx.wr * 64 + m * 16 + cx.fr) * D + col0 + bj * 128);
#pragma unroll
            for (int m = 0; m < 4; ++m) { const int rl = ai * 128 + cx.wr * 64 + m * 16 + cx.fr; const size_t off = (size_t)(u.pm * 256 + rl) * D + col0; float ss = 0.f;
#pragma unroll
                for (int bj = 0; bj < 2; ++bj) { const u32x4 xv = xo[m][bj];
                    const f32x4 v0 = (f32x4){bflo(xv.x), bfhi(xv.x), bflo(xv.y), bfhi(xv.y)} + acc[ai][bj][m][0], v1 = (f32x4){bflo(xv.z), bfhi(xv.z), bflo(xv.w), bfhi(xv.w)} + acc[ai][bj][m][1];
                    *(u32x4*)(xb + off + bj * 128) = pack8(v0, v1);
                    ss += ((v0[0] * v0[0] + v0[1] * v0[1]) + (v0[2] * v0[2] + v0[3] * v0[3])) + ((v1[0] * v1[0] + v1[1] * v1[1]) + (v1[2] * v1[2] + v1[3] * v1[3])); }
                ss = red_fq(ss); if (cx.fq == 0) T[rl * 4 + cx.wc] = ss; }
            asm volatile("" ::: "memory"); }
        LDS_BAR();
        const int tid = cx.wid * 64 + cx.lane;
        if (tid < 256) { const f32x4 t = *(const LAS f32x4*)(T + tid * 4); rsp_out[(size_t)(u.pm * 256 + tid) * 4 + u.pn] = (t[0] + t[1]) + (t[2] + t[3]); }
    }
};
struct EpiBf { static constexpr bool PERM = true; static constexpr bool RSPRE = false;
    bf16_t* O; int ldc; const float* rsv; int rs_mode; int split_pn; bf16_t* O2; int ldc2; int pn_stride;
    __device__ __forceinline__ void operator()(AccRef acc, const Unit& u, const EpiCtx& cx) const {
        bf16_t* base = O; int ld = ldc, pn = u.pn; if (pn >= split_pn) { base = O2; ld = ldc2; pn -= split_pn; }
        const size_t col0 = (size_t)pn * pn_stride + cx.wc * 32 + 8 * cx.fq;
        float rsa[2][4];
        if (rs_mode == 1) load_rs(rsv, u, cx, 1.0f / 1024.f, 1e-6f, rsa);
        else {
#pragma unroll
            for (int ai = 0; ai < 2; ++ai)
#pragma unroll
                for (int m = 0; m < 4; ++m) rsa[ai][m] = rs_mode == 2 ? rsv[u.pm * 256 + ai * 128 + cx.wr * 64 + m * 16 + cx.fr] : 1.f; }
#pragma unroll
        for (int ai = 0; ai < 2; ++ai)
#pragma unroll
            for (int m = 0; m < 4; ++m) { const int row = u.pm * 256 + ai * 128 + cx.wr * 64 + m * 16 + cx.fr; const float rs = rsa[ai][m];
                bf16_t* rowp = base + (size_t)row * ld + col0;
#pragma unroll
                for (int bj = 0; bj < 2; ++bj) *(u32x4*)(rowp + bj * 128) = pack8(acc[ai][bj][m][0] * rs, acc[ai][bj][m][1] * rs); }
    }
};
struct EpiS { static constexpr bool PERM = true; static constexpr bool RSPRE = true;
    __device__ __forceinline__ const float* rs_src() const { return rsp; }
    bf16_t* P; const float* rsp;
    __device__ __forceinline__ void operator()(AccRef acc, const Unit& u, const EpiCtx& cx) const {
        LAS float* MX = (LAS float*)cx.xl; LAS float* SM = MX + 1024;
        const float sc = 0.0625f * 1.4426950408889634f;
        { float rs[2][4]; load_rs_lds(cx, 1.0f / 1024.f, 1e-6f, rs);
#pragma unroll
          for (int ai = 0; ai < 2; ++ai)
#pragma unroll
              for (int m = 0; m < 4; ++m)
#pragma unroll
                  for (int bj = 0; bj < 2; ++bj)
#pragma unroll
                      for (int n = 0; n < 2; ++n) acc[ai][bj][m][n] = acc[ai][bj][m][n] * rs[ai][m]; }
#pragma unroll
        for (int ai = 0; ai < 2; ++ai)
#pragma unroll
            for (int m = 0; m < 4; ++m) { const int rl = ai * 128 + cx.wr * 64 + m * 16 + cx.fr; float mx = -3.0e38f;
#pragma unroll
                for (int bj = 0; bj < 2; ++bj)
#pragma unroll
                    for (int n = 0; n < 2; ++n) { const f32x4 v = acc[ai][bj][m][n]; mx = fmaxf(mx, fmaxf(fmaxf(v[0], v[1]), fmaxf(v[2], v[3]))); }
                mx = max_fq(mx); if (cx.fq == 0) MX[rl * 4 + cx.wc] = mx; }
        LDS_BAR();
#pragma unroll
        for (int ai = 0; ai < 2; ++ai)
#pragma unroll
            for (int m = 0; m < 4; ++m) { const int rl = ai * 128 + cx.wr * 64 + m * 16 + cx.fr; const f32x4 t = *(const LAS f32x4*)(MX + rl * 4);
                const float mx = fmaxf(fmaxf(t[0], t[1]), fmaxf(t[2], t[3])) * sc; float s = 0.f;
#pragma unroll
                for (int bj = 0; bj < 2; ++bj)
#pragma unroll
                    for (int n = 0; n < 2; ++n) { f32x4 v = acc[ai][bj][m][n];
#pragma unroll
                        for (int i = 0; i < 4; ++i) { v[i] = fast_exp2(v[i] * sc - mx); s += v[i]; }
                        acc[ai][bj][m][n] = v; }
                s = red_fq(s); if (cx.fq == 0) SM[rl * 4 + cx.wc] = s; }
        LDS_BAR();
        const int col0 = u.pn * 256 + cx.wc * 32 + 8 * cx.fq;
#pragma unroll
        for (int ai = 0; ai < 2; ++ai)
#pragma unroll
            for (int m = 0; m < 4; ++m) { const int rl = ai * 128 + cx.wr * 64 + m * 16 + cx.fr; const f32x4 t = *(const LAS f32x4*)(SM + rl * 4);
                const float inv = fast_rcp((t[0] + t[1]) + (t[2] + t[3])); bf16_t* rowp = P + (size_t)(u.pm * 256 + rl) * D + col0;
#pragma unroll
                for (int bj = 0; bj < 2; ++bj) *(u32x4*)(rowp + bj * 128) = pack8(acc[ai][bj][m][0] * inv, acc[ai][bj][m][1] * inv); }
    }
};
struct EpiFfn1 { static constexpr bool PERM = true; static constexpr bool RSPRE = true;
    bf16_t* ACT; const float* rsp;
    __device__ __forceinline__ const float* rs_src() const { return rsp; }
    __device__ __forceinline__ void operator()(AccRef acc, const Unit& u, const EpiCtx& cx) const {
        const int col0 = u.pn * 128 + cx.wc * 32 + 8 * cx.fq;
        float rsa[2][4]; load_rs_lds(cx, 1.0f / 1024.f, 1e-6f, rsa);
        LDS_BAR();
#pragma unroll
        for (int ai = 0; ai < 2; ++ai)
#pragma unroll
            for (int m = 0; m < 4; ++m) { const int row = u.pm * 256 + ai * 128 + cx.wr * 64 + m * 16 + cx.fr;
                const float rs = rsa[ai][m]; f32x4 o[2];
#pragma unroll
                for (int n = 0; n < 2; ++n)
#pragma unroll
                    for (int i = 0; i < 4; ++i) o[n][i] = silu_f(acc[ai][0][m][n][i] * rs) * (acc[ai][1][m][n][i] * rs);
                *(u32x4*)(ACT + (size_t)row * FF + col0) = pack8(o[0], o[1]); }
    }
};
template <int CTRL> __device__ __forceinline__ float dppf(float v) { return __builtin_bit_cast(float, __builtin_amdgcn_update_dpp(0, __builtin_bit_cast(int, v), CTRL, 0xf, 0xf, true)); }
__device__ __forceinline__ float row_scan16(float v) { v += dppf<0x111>(v); v += dppf<0x112>(v); v += dppf<0x114>(v); v += dppf<0x118>(v); return v; }
__device__ __forceinline__ float row_last16(float v) { return dppf<0x15F>(v); }
__device__ __forceinline__ float row_sum16(float v) { v += dppf<0x128>(v); v += dppf<0x124>(v); v += dppf<0x122>(v); v += dppf<0x121>(v); return v; }

struct EpiIn0 { static constexpr bool PERM = true; static constexpr bool RSPRE = true;
    unsigned char* ws;
    __device__ __forceinline__ const float* rs_src() const { return (const float*)(ws + WS_RSP); }
    __device__ __forceinline__ void operator()(AccRef acc, const Unit& u, const EpiCtx& cx) const {
        const float* rsp = (const float*)(ws + WS_RSP); const float* lb = (const float*)(ws + WS_LB); bf16_t* QE = (bf16_t*)(ws + WS_QE); bf16_t* KINV = (bf16_t*)(ws + WS_KINV); bf16_t* HZ = (bf16_t*)(ws + WS_HZ); float* EBG = (float*)(ws + WS_EBG);
        float rs[2][4]; load_rs_lds(cx, 1.0f / 1024.f, 1e-6f, rs); (void)rsp;
        LDS_BAR();
        const int pn = u.pn;
        if (pn < 4) {
            const int ch0 = pn * 128 + cx.wc * 32 + 8 * cx.fq;
#pragma unroll
            for (int ai = 0; ai < 2; ++ai) {
                const int row0 = u.pm * 256 + ai * 128 + cx.wr * 64;
#pragma unroll
                for (int n = 0; n < 2; ++n) {
                    const f32x4 lbv = *(const f32x4*)(lb + ch0 + 4 * n);
                    f32x4 oq[4], oi[4], eb;
#pragma unroll
                    for (int i = 0; i < 4; ++i) {
                        float l2[4], kk[4], tot[4];
#pragma unroll
                        for (int m = 0; m < 4; ++m) { const float x = acc[ai][1][m][n][i] * rs[ai][m]; const float f = lbv[i] + (1.0f - lbv[i]) * sigmoid_f(x);
                            kk[m] = 1.0f - f; l2[m] = row_scan16(__builtin_amdgcn_logf(f)); tot[m] = row_last16(l2[m]); }
                        const float btot = (tot[0] + tot[1]) + (tot[2] + tot[3]); float pre = 0.f;
#pragma unroll
                        for (int m = 0; m < 4; ++m) { const float b = l2[m] + pre; pre += tot[m];
                            const float q = silu_f(acc[ai][0][m][n][i] * rs[ai][m]);
                            oq[m][i] = q * fast_exp2(b); oi[m][i] = kk[m] * fast_exp2(fminf(-b, 100.f)); }
                        eb[i] = fast_exp2(btot);
                    }
#pragma unroll
                    for (int m = 0; m < 4; ++m) { const size_t o = (size_t)(row0 + m * 16 + cx.fr) * 512 + ch0 + 4 * n;
                        *(u32x2*)(QE + o) = pack4(oq[m]); *(u32x2*)(KINV + o) = pack4(oi[m]); }
                    if (cx.fr == 0) *(f32x4*)(EBG + (size_t)(row0 >> 6) * 512 + ch0 + 4 * n) = eb;
                    __builtin_amdgcn_sched_barrier(0);
                }
            }
        } else if (pn < 10) {
            bf16_t* T = (bf16_t*)(ws + (pn < 6 ? WS_HV : (pn < 8 ? WS_HG : WS_HB))); const bool act = (pn == 6 || pn == 7);
            const int col0 = (pn & 1) * 256 + cx.wc * 32 + 8 * cx.fq;
#pragma unroll
            for (int ai = 0; ai < 2; ++ai)
#pragma unroll
                for (int m = 0; m < 4; ++m) { const int row = u.pm * 256 + ai * 128 + cx.wr * 64 + m * 16 + cx.fr; const float r = rs[ai][m];
#pragma unroll
                    for (int bj = 0; bj < 2; ++bj) { f32x4 a = acc[ai][bj][m][0] * r, b = acc[ai][bj][m][1] * r;
                        if (act) {
#pragma unroll
                            for (int i = 0; i < 4; ++i) { a[i] = silu_f(a[i]); b[i] = silu_f(b[i]); } }
                        *(u32x4*)(T + (size_t)row * 512 + col0 + bj * 128) = pack8(a, b); } }
        } else {
            const int col0 = (pn - 10) * 128 + cx.wc * 32 + 8 * cx.fq;
#pragma unroll
            for (int ai = 0; ai < 2; ++ai)
#pragma unroll
                for (int m = 0; m < 4; ++m) { const int row = u.pm * 256 + ai * 128 + cx.wr * 64 + m * 16 + cx.fr; const float r2 = rs[ai][m] * rs[ai][m];
                    *(u32x4*)(HZ + (size_t)row * 512 + col0) = pack8(acc[ai][0][m][0] * acc[ai][1][m][0] * r2, acc[ai][0][m][1] * acc[ai][1][m][1] * r2); }
        }
    }
};
__device__ __forceinline__ unsigned off_b(unsigned row, unsigned ch) { return 256u * row + 16u * (ch ^ (((row & 3) << 2) | ((row >> 2) & 3))); }
__device__ __forceinline__ s16x4 ldtr(const LAS unsigned char* p) { return __builtin_amdgcn_ds_read_tr16_b64_v4i16((LAS s16x4*)p); }
__device__ __forceinline__ bf16x8 mk8(s16x4 a, s16x4 b) { return (bf16x8){a[0], a[1], a[2], a[3], b[0], b[1], b[2], b[3]}; }
__device__ __forceinline__ s16x4 tr_blk(const LAS unsigned char* img, int r0, int c, int lane) { const int q = (lane & 15) >> 2, p = lane & 3; return ldtr(img + off_b(r0 + q, 2 * c + (p >> 1)) + 8 * (p & 1)); }
__device__ __forceinline__ void unpack8(u32x4 w, float (&f)[8]) { f[0] = bflo(w.x); f[1] = bfhi(w.x); f[2] = bflo(w.y); f[3] = bfhi(w.y); f[4] = bflo(w.z); f[5] = bfhi(w.z); f[6] = bflo(w.w); f[7] = bfhi(w.w); }
__device__ __forceinline__ u32x4 pack8f(const float (&f)[8]) { u32x4 w; w.x = cvt_pk_bf16(f[0], f[1]); w.y = cvt_pk_bf16(f[2], f[3]); w.z = cvt_pk_bf16(f[4], f[5]); w.w = cvt_pk_bf16(f[6], f[7]); return w; }
#define MFMA16(A, B, C) __builtin_amdgcn_mfma_f32_16x16x32_bf16((A), (B), (C), 0, 0, 0)

constexpr int HG_BUF = 66048, HG_ATT = 2 * HG_BUF, HG_ATT_ROW = 144;
constexpr int HG_NSEG = 8, HG_SEGC = (SEQ / 64) / HG_NSEG;
__device__ __forceinline__ void hgrn_unit(const Frame& F, unsigned char* ws, int unit) {
    const int b = unit >> 5, h = (unit >> 3) & 3, seg = unit & 7, c0 = seg * HG_SEGC;
    const int tid = F.tid, lane0 = F.lane, w = F.wave;
    const unsigned char* gsrc = ws + WS_BIG1; const float* EBG = (const float*)(ws + WS_EBG); bf16_t* HO = (bf16_t*)(ws + WS_HO);
    LAS unsigned char* L = F.lds; LAS unsigned char* ATT = L + HG_ATT;
    u32x4 st[8]; f32x4 steb = (f32x4){0.f, 0.f, 0.f, 0.f};
    const int srow = (tid & 511) >> 4, sch = tid & 15;
#define HG_LOAD(ci) do { const size_t tok0_ = (size_t)b * SEQ + (size_t)(ci) * 64; \
        _Pragma("unroll") for (int j = 0; j < 8; ++j) if ((j >> 1) != 2) st[j] = *(const u32x4*)(gsrc + (size_t)(j >> 1) * T64 + ((tok0_ + srow + 32 * (j & 1)) * 512 + h * 128 + sch * 8) * 2); \
        if (tid < 32) steb = *(const f32x4*)(EBG + (tok0_ >> 6) * 512 + h * 128 + 4 * tid); } while (0)
#define HG_STORE(bufi) do { LAS unsigned char* B_ = L + (bufi) * HG_BUF; \
        _Pragma("unroll") for (int j = 0; j < 8; ++j) if ((j >> 1) != 2) *(LAS u32x4*)(B_ + (j >> 1) * 16384 + off_b(srow + 32 * (j & 1), sch)) = st[j]; \
        if (tid < 32) *(LAS f32x4*)(B_ + 65536 + 16 * tid) = steb; } while (0)
    f32x4 S[8];
#pragma unroll
    for (int kt = 0; kt < 8; ++kt) S[kt] = (f32x4){0.f, 0.f, 0.f, 0.f};
    {
      const float* SLOC = (const float*)(ws + WS_SLOC); const float* DSEG = (const float*)(ws + WS_DSEG); const int g_ = lane0 >> 4, c_ = lane0 & 15;
      f32x4 cum[8];
#pragma unroll
      for (int kt = 0; kt < 8; ++kt) cum[kt] = (f32x4){1.f, 1.f, 1.f, 1.f};
      for (int j = seg - 1; j >= 0; --j) { const int uj = (unit & ~7) | j; const float* sl = SLOC + (size_t)uj * 16384 + (size_t)(g_ * 128 + 16 * w + c_) * 4; const float* dj = DSEG + (size_t)uj * 128;
#pragma unroll
          for (int kt = 0; kt < 8; ++kt) { const f32x4 d4 = *(const f32x4*)(dj + 16 * kt + 4 * g_); const f32x4 s4 = *(const f32x4*)(sl + kt * 2048);
              S[kt] = S[kt] + cum[kt] * s4;
              cum[kt] = cum[kt] * d4; } } }
    HG_LOAD(c0); HG_STORE(0); LDS_BAR();
    for (int cr = 0; cr < HG_SEGC; ++cr) { const int ci = c0 + cr;
        const LAS unsigned char* B = L + (cr & 1) * HG_BUF; const LAS unsigned char* bQE = B; const LAS unsigned char* bKI = B + 16384; const LAS unsigned char* bKD = B + 32768; const LAS unsigned char* bV = B + 49152;
        const size_t tok0 = (size_t)b * SEQ + (size_t)ci * 64;
        const int lane = opq(lane0), g = lane >> 4, c = lane & 15;
        if (cr + 1 < HG_SEGC) HG_LOAD(ci + 1);
#pragma unroll
        for (int e = 0; e < 2; ++e) { const int id = 2 * w + e, mt = id >> 2, ns = id & 3; f32x4 acc = (f32x4){0.f, 0.f, 0.f, 0.f};
            if (mt >= ns) {
#pragma unroll
                for (int ks = 0; ks < 4; ++ks) { const bf16x8 Bq = *(const LAS bf16x8*)(bQE + off_b(16 * mt + c, 4 * ks + g)); const bf16x8 Ak = *(const LAS bf16x8*)(bKI + off_b(16 * ns + c, 4 * ks + g)); acc = MFMA16(Ak, Bq, acc); }
            }
            f32x4 v;
#pragma unroll
            for (int i = 0; i < 4; ++i) { const bool keep = (mt > ns) || (mt == ns && 4 * g + i <= c); v[i] = keep ? acc[i] : 0.f; }
            *(LAS u32x2*)(ATT + (16 * mt + c) * HG_ATT_ROW + (16 * ns + 4 * g) * 2) = pack4(v); }
        LDS_BAR();
        bf16x8 Sb[4];
#pragma unroll
        for (int ks = 0; ks < 4; ++ks) { u32x4 p; p.x = cvt_pk_bf16(S[2 * ks][0], S[2 * ks][1]); p.y = cvt_pk_bf16(S[2 * ks][2], S[2 * ks][3]); p.z = cvt_pk_bf16(S[2 * ks + 1][0], S[2 * ks + 1][1]); p.w = cvt_pk_bf16(S[2 * ks + 1][2], S[2 * ks + 1][3]); Sb[ks] = __builtin_bit_cast(bf16x8, p); }
        bf16x8 Vf[2];
#pragma unroll
        for (int k2 = 0; k2 < 2; ++k2) {
#if HG_DBG & 8
            bf16x8 t;
#pragma unroll
            for (int j = 0; j < 8; ++j) { const int srow_ = 32 * k2 + 8 * g + j, vcol = 16 * w + c; t[j] = *(const LAS short*)(bV + off_b(srow_, vcol >> 3) + (vcol & 7) * 2); }
            Vf[k2] = t;
#else
            Vf[k2] = mk8(tr_blk(bV, 32 * k2 + 8 * g, w, lane), tr_blk(bV, 32 * k2 + 8 * g + 4, w, lane));
#endif
        }
        f32x4 ao[4];
#pragma unroll
        for (int mt = 0; mt < 4; ++mt) { ao[mt] = (f32x4){0.f, 0.f, 0.f, 0.f};
#pragma unroll
            for (int ks = 0; ks < 4; ++ks) { const s16x4 a0 = *(const LAS s16x4*)(bQE + off_b(16 * mt + c, 4 * ks + (g >> 1)) + 8 * (g & 1)); const s16x4 a1 = *(const LAS s16x4*)(bQE + off_b(16 * mt + c, 4 * ks + 2 + (g >> 1)) + 8 * (g & 1));
                if (!(HG_DBG & 1)) ao[mt] = MFMA16(Sb[ks], mk8(a0, a1), ao[mt]); }
#pragma unroll
            for (int k2 = 0; k2 < 2; ++k2) { const bf16x8 A = *(const LAS bf16x8*)(ATT + (16 * mt + c) * HG_ATT_ROW + (32 * k2 + 8 * g) * 2); if (!(HG_DBG & 2)) ao[mt] = MFMA16(Vf[k2], A, ao[mt]); } }
#pragma unroll
        for (int mt = 0; mt < 4; ++mt) *(u32x2*)(HO + (tok0 + 16 * mt + c) * 512 + h * 128 + 16 * w + 4 * g) = pack4(ao[mt]);
#pragma unroll
        for (int kt = 0; kt < 8; ++kt) { const f32x4 e4 = *(const LAS f32x4*)(B + 65536 + (16 * kt + 4 * g) * 4); f32x4 X = (f32x4){0.f, 0.f, 0.f, 0.f};
#pragma unroll
            for (int k2 = 0; k2 < 2; ++k2) { const bf16x8 A = mk8(tr_blk(bKI, 32 * k2 + 8 * g, kt, lane), tr_blk(bKI, 32 * k2 + 8 * g + 4, kt, lane)); X = MFMA16(A, Vf[k2], X); }
            S[kt] = S[kt] * e4 + X * e4; }
        if (cr + 1 < HG_SEGC) HG_STORE((cr + 1) & 1);
        LDS_BAR();
    }
#undef HG_LOAD
#undef HG_STORE
    WG_BAR();
    { const bf16_t* HG = (const bf16_t*)(ws + WS_HG); bf16_t* A0 = (bf16_t*)(ws + WS_A0); const int tl = lane0 >> 4, j = lane0 & 15; float gn[8];
#pragma unroll
      for (int i = 0; i < 8; ++i) gn[i] = INP(I_EAON)[h * 128 + 8 * j + i];
      const size_t tokf = (size_t)b * SEQ + (size_t)c0 * 64 + w * 128 + tl;
      u32x4 no_ = *(const u32x4*)(HO + tokf * 512 + h * 128 + 8 * j), ng_ = *(const u32x4*)(HG + tokf * 512 + h * 128 + 8 * j);
      for (int it = 0; it < 32; ++it) { const size_t tok = tokf + it * 4; const u32x4 co_ = no_, cg_ = ng_;
          if (it + 1 < 32) { const size_t offn = (tok + 4) * 512 + h * 128 + 8 * j; no_ = *(const u32x4*)(HO + offn); ng_ = *(const u32x4*)(HG + offn); }
          float o[8], gt[8], r[8]; unpack8(co_, o); unpack8(cg_, gt);
          float ss = 0.f;
#pragma unroll
          for (int i = 0; i < 8; ++i) ss += o[i] * o[i];
          ss = row_sum16(ss);
          const float rr = fast_rsq(ss * (1.0f / 128.f) + 1e-6f);
#pragma unroll
          for (int i = 0; i < 8; ++i) r[i] = o[i] * rr * gn[i] * gt[i];
          *(u32x4*)(A0 + tok * 1024 + h * 128 + 8 * j) = pack8f(r); } }
}
__device__ __forceinline__ void hgrn_passA(const Frame& F, unsigned char* ws, int unit) {
    const int b = unit >> 5, h = (unit >> 3) & 3, seg = unit & 7, c0 = seg * HG_SEGC;
    const int tid = F.tid, lane0 = F.lane, w = F.wave;
    const unsigned char* gsrc = ws + WS_BIG1; const float* EBG = (const float*)(ws + WS_EBG);
    LAS unsigned char* L = F.lds;
    constexpr int PA_BUF = 33280;
    u32x4 st[4]; f32x4 steb = (f32x4){0.f, 0.f, 0.f, 0.f};
    const int srow = (tid & 511) >> 4, sch = tid & 15;
#define PA_LOAD(ci) do { const size_t tok0_ = (size_t)b * SEQ + (size_t)(ci) * 64; \
        _Pragma("unroll") for (int j = 0; j < 4; ++j) st[j] = *(const u32x4*)(gsrc + (size_t)((j >> 1) ? 3 : 1) * T64 + ((tok0_ + srow + 32 * (j & 1)) * 512 + h * 128 + sch * 8) * 2); \
        if (tid < 32) steb = *(const f32x4*)(EBG + (tok0_ >> 6) * 512 + h * 128 + 4 * tid); } while (0)
#define PA_STORE(bufi) do { LAS unsigned char* B_ = L + (bufi) * PA_BUF; \
        _Pragma("unroll") for (int j = 0; j < 4; ++j) *(LAS u32x4*)(B_ + (j >> 1) * 16384 + off_b(srow + 32 * (j & 1), sch)) = st[j]; \
        if (tid < 32) *(LAS f32x4*)(B_ + 32768 + 16 * tid) = steb; } while (0)
    f32x4 S[8], dc[8];
#pragma unroll
    for (int kt = 0; kt < 8; ++kt) { S[kt] = (f32x4){0.f, 0.f, 0.f, 0.f}; dc[kt] = (f32x4){1.f, 1.f, 1.f, 1.f}; }
    PA_LOAD(c0); PA_STORE(0); LDS_BAR();
    for (int cr = 0; cr < HG_SEGC; ++cr) {
        const LAS unsigned char* B = L + (cr & 1) * PA_BUF; const LAS unsigned char* bKD = B; const LAS unsigned char* bV = B + 16384;
        const int lane = opq(lane0), g = lane >> 4;
        if (cr + 1 < HG_SEGC) PA_LOAD(c0 + cr + 1);
        bf16x8 Vf[2];
#pragma unroll
        for (int k2 = 0; k2 < 2; ++k2) Vf[k2] = mk8(tr_blk(bV, 32 * k2 + 8 * g, w, lane), tr_blk(bV, 32 * k2 + 8 * g + 4, w, lane));
#pragma unroll
        for (int kt = 0; kt < 8; ++kt) { const f32x4 e4 = *(const LAS f32x4*)(B + 32768 + (16 * kt + 4 * g) * 4); dc[kt] = dc[kt] * e4; f32x4 X = (f32x4){0.f, 0.f, 0.f, 0.f};
#pragma unroll
            for (int k2 = 0; k2 < 2; ++k2) { const bf16x8 A = mk8(tr_blk(bKD, 32 * k2 + 8 * g, kt, lane), tr_blk(bKD, 32 * k2 + 8 * g + 4, kt, lane)); X = MFMA16(A, Vf[k2], X); }
            S[kt] = S[kt] * e4 + X * e4; }
        if (cr + 1 < HG_SEGC) PA_STORE((cr + 1) & 1);
        LDS_BAR();
    }
    { const int g = lane0 >> 4; float* sl = (float*)(ws + WS_SLOC) + (size_t)unit * 16384 + (size_t)(g * 128 + 16 * w + (lane0 & 15)) * 4; float* dj = (float*)(ws + WS_DSEG) + (size_t)unit * 128;
#pragma unroll
      for (int kt = 0; kt < 8; ++kt) {
          *(f32x4*)(sl + kt * 2048) = S[kt];
          if (w == 0 && (lane0 & 15) == 0) *(f32x4*)(dj + 16 * kt + 4 * g) = dc[kt]; } }
#undef PA_LOAD
#undef PA_STORE
}
__device__ __forceinline__ void conv_part(const Frame& F, unsigned char* ws, int wg, int nwg) {
    const bf16_t* HZ = (const bf16_t*)(ws + WS_HZ); const bf16_t* HB = (const bf16_t*)(ws + WS_HB); bf16_t* A0 = (bf16_t*)(ws + WS_A0);
    const float* wc = INP(I_EBCONV); const int T = wg * NTHR + F.tid, NT = nwg * NTHR, cg = T & 63;
    float w0[8], w1[8], w2[8];
#pragma unroll
    for (int j = 0; j < 8; ++j) { w0[j] = wc[cg * 8 + j]; w1[j] = wc[512 + cg * 8 + j]; w2[j] = wc[1024 + cg * 8 + j]; }
    for (int u = T; u < (M / 16) * 64; u += NT) { const size_t tok0 = (size_t)(u >> 6) * 16; const bool first = (tok0 & (SEQ - 1)) == 0;
        float z2[8], z1[8];
        if (first) {
#pragma unroll
            for (int j = 0; j < 8; ++j) { z2[j] = 0.f; z1[j] = 0.f; } }
        else { unpack8(*(const u32x4*)(HZ + (tok0 - 2) * 512 + cg * 8), z2); unpack8(*(const u32x4*)(HZ + (tok0 - 1) * 512 + cg * 8), z1); }
        for (int i = 0; i < 16; ++i) { float z0[8], bb[8], o[8]; unpack8(*(const u32x4*)(HZ + (tok0 + i) * 512 + cg * 8), z0); unpack8(*(const u32x4*)(HB + (tok0 + i) * 512 + cg * 8), bb);
#pragma unroll
            for (int j = 0; j < 8; ++j) { o[j] = bb[j] * (w0[j] * z2[j] + w1[j] * z1[j] + w2[j] * z0[j]); z2[j] = z1[j]; z1[j] = z0[j]; }
            *(u32x4*)(A0 + (tok0 + i) * 1024 + 512 + cg * 8) = pack8f(o); }
    }
}
__device__ __forceinline__ void hgrn_finalize(const Frame& F, unsigned char* ws) {
    const bf16_t* HO = (const bf16_t*)(ws + DBG_FIN_SRC); const bf16_t* HG = (const bf16_t*)(ws + WS_HG); bf16_t* A0 = (bf16_t*)(ws + WS_A0);
    const int hh = F.lane >> 4, j = F.lane & 15; float gn[8];
#pragma unroll
    for (int i = 0; i < 8; ++i) gn[i] = INP(I_EAON)[hh * 128 + 8 * j + i];
    for (int tok = F.gw; tok < M; tok += F.NGW) { const size_t off = (size_t)tok * 512 + hh * 128 + 8 * j; float o[8], gt[8], r[8]; unpack8(*(const u32x4*)(HO + off), o); unpack8(*(const u32x4*)(HG + off), gt);
        float ss = 0.f;
#pragma unroll
        for (int i = 0; i < 8; ++i) ss += o[i] * o[i];
        ss = row_sum16(ss);
        const float rr = fast_rsq(ss * (1.0f / 128.f) + 1e-6f);
#pragma unroll
        for (int i = 0; i < 8; ++i) r[i] = o[i] * rr * gn[i] * gt[i];
        *(u32x4*)(A0 + (size_t)tok * 1024 + hh * 128 + 8 * j) = pack8f(r); }
}
__device__ __forceinline__ void gmlp_load(const Frame& F, unsigned char* ws, int unit, u32x4 (&dv)[4]) {
    const int grp = unit & 3, cidx = unit >> 2; const size_t tok0 = (size_t)cidx * 128; const bf16_t* DV = (const bf16_t*)(ws + WS_DV); const int tid = opq(F.tid);
#pragma unroll
    for (int j = 0; j < 4; ++j) { const int pc = tid + 512 * j, s = pc >> 4, ch = pc & 15; dv[j] = *(const u32x4*)(DV + (tok0 + s) * 512 + grp * 128 + ch * 8); }
}
__device__ __forceinline__ void gmlp_unit(const Frame& F, unsigned char* ws, int unit, const u32x4 (&dvc)[4], u32x4 (&dvn)[4], int next_unit) {
    const int grp = unit & 3, cidx = unit >> 2; const size_t tok0 = (size_t)cidx * 128;
    const bf16_t* DV = (const bf16_t*)(ws + WS_DV); const bf16_t* U = (const bf16_t*)(ws + WS_U); const bf16_t* WC = (const bf16_t*)(ws + WS_WC);
    bf16_t* A1 = (bf16_t*)(ws + WS_A1); const float* bs = INP(I_ODBS);
    const int tid = opq(F.tid), lane = tid & 63, w = F.wave, g4 = lane >> 4, c = lane & 15; LAS unsigned char* VN = F.lds;
#pragma unroll
    for (int j = 0; j < 4; ++j) { const int pc = tid + 512 * j, s = pc >> 4, ch = pc & 15; *(LAS u32x4*)(VN + off_b(s, ch)) = dvc[j]; }
    if (next_unit >= 0) gmlp_load(F, ws, next_unit, dvn);
    bf16x8 Bf[4]; const int nks = (w >> 1) + 1;
#pragma unroll
    for (int ks = 0; ks < 4; ++ks) Bf[ks] = *(const bf16x8*)(WC + ((size_t)grp * 128 + 16 * w + c) * 128 + 32 * ks + 8 * g4);
    LDS_BAR();
    const size_t tok = tok0 + 16 * w + c; const float bias = bs[grp * 128 + 16 * w + c];
    u32x2 uua[8];
#pragma unroll
    for (int mt = 0; mt < 8; ++mt) uua[mt] = *(const u32x2*)(U + tok * 512 + grp * 128 + 16 * mt + 4 * g4);
#pragma unroll
    for (int mt = 0; mt < 8; ++mt) { f32x4 acc = (f32x4){0.f, 0.f, 0.f, 0.f};
#pragma unroll
        for (int ks = 0; ks < 4; ++ks) if (ks < nks) { const bf16x8 A = mk8(tr_blk(VN, 32 * ks + 8 * g4, mt, lane), tr_blk(VN, 32 * ks + 8 * g4 + 4, mt, lane)); acc = MFMA16(A, Bf[ks], acc); }
        const int ch = grp * 128 + 16 * mt + 4 * g4; const u32x2 uu = uua[mt];
        f32x4 o; o[0] = bflo(uu.x) * (acc[0] + bias); o[1] = bfhi(uu.x) * (acc[1] + bias); o[2] = bflo(uu.y) * (acc[2] + bias); o[3] = bfhi(uu.y) * (acc[3] + bias);
        *(u32x2*)(A1 + tok * 1536 + 1024 + ch) = pack4(o);
        if (mt & 1) __builtin_amdgcn_sched_barrier(0); }
    LDS_BAR();
}

constexpr int DS_HIST = 0, DS_OIDX = 131072, DS_WQ = 147456, DS_ST = 148480, DS_PEND = 149504, DS_QBAR = 149632;
constexpr unsigned DS_SELALL = 99u, DS_CAP = 512u;
__device__ __forceinline__ unsigned lds_add(LAS unsigned* p, unsigned v) { return __hip_atomic_fetch_add(p, v, __ATOMIC_RELAXED, __HIP_MEMORY_SCOPE_WORKGROUP); }
__device__ __forceinline__ unsigned lds_or(LAS unsigned* p, unsigned v) { return __hip_atomic_fetch_or(p, v, __ATOMIC_RELAXED, __HIP_MEMORY_SCOPE_WORKGROUP); }
__device__ __forceinline__ unsigned f2key(float s) { unsigned u = __float_as_uint(s); if (u == 0x80000000u) u = 0u; return (u & 0x80000000u) ? ~u : (u | 0x80000000u); }

__device__ __forceinline__ int lin_bin(float s) { return (int)__builtin_amdgcn_fmed3f(__builtin_fmaf(s, 128.f, 1024.f), 0.f, 2047.f); }
template <bool V> struct BoolC { static constexpr bool v = V; };
template <int MODE, bool LVL0>
__device__ __forceinline__ void dsa_pass(const bf16x8 (&afr)[4][4], const LAS unsigned char* alin_p, const bf16_t* KI, int t0, LAS unsigned char* L, int w, int lane, int lvl, unsigned short* scr) {
    const int h2 = lane >> 5, c = lane & 31, nkt = (t0 >> 5) + 1;
    LAS unsigned* ST = (LAS unsigned*)(L + DS_ST); const LAS float* WQ = (const LAS float*)(L + DS_WQ);
    LAS unsigned short* OIDX = (LAS unsigned short*)(L + DS_OIDX); LAS unsigned long long* CAND = (LAS unsigned long long*)(L + DS_HIST);
    const int mt0 = (w >> 2) * 4;
    int qa[4][2]; unsigned actm = 0u;
#pragma unroll
    for (int mt = 0; mt < 4; ++mt)
#pragma unroll
        for (int i = 0; i < 2; ++i) { const int q = 4 * (mt0 + mt) + 2 * h2 + i; const unsigned plen = ST[q * 8 + 1], lb1 = ST[q * 8 + 6];
            if (MODE == 0 && LVL0) { qa[mt][i] = 0; actm |= (ST[q * 8 + 5] == 0u) ? (1u << (2 * mt + i)) : 0u; }
            else if (MODE == 0) qa[mt][i] = (ST[q * 8 + 5] == 0u) ? (int)lb1 : -1000;
            else qa[mt][i] = (int)(lb1 | ((plen == DS_SELALL ? 0u : 32u - plen) << 16)); }
    const unsigned sh1 = lvl >= 2 ? 32u - 11u * (unsigned)(lvl - 1) : 0u, sh2 = lvl == 1 ? 21u : (lvl == 2 ? 10u : 0u), bmask = lvl == 3 ? 1023u : 2047u;
    f32x4 wreg[4][2][2];
#pragma unroll
    for (int mt = 0; mt < 4; ++mt)
#pragma unroll
        for (int i = 0; i < 2; ++i) { const int q = 4 * (mt0 + mt) + 2 * h2 + i; if (MODE != 1) { wreg[mt][i][0] = *(const LAS f32x4*)(WQ + q * 8); wreg[mt][i][1] = *(const LAS f32x4*)(WQ + q * 8 + 4); } }
    LAS unsigned char* hbase = L + DS_HIST + (2 * h2 + 4 * mt0) * 4096;
    constexpr bool PF = false && (MODE == 0 && LVL0);
    bf16x8 bnx[4];
    if (PF && (w & 3) < nkt) {
#pragma unroll
        for (int ks = 0; ks < 4; ++ks) bnx[ks] = *(const bf16x8*)(KI + (size_t)((w & 3) * 32 + c) * 64 + 16 * ks + 8 * h2); }
    for (int kt = (w & 3); kt < nkt; kt += 4) {
        const int key0 = kt * 32; const bool lastt = (kt == nkt - 1);
        const int c2 = (lastt ? c : 0) - 2 * h2;
        bf16x8 bfr[4];
        if (PF) {
#pragma unroll
            for (int ks = 0; ks < 4; ++ks) bfr[ks] = bnx[ks];
            if (kt + 4 < nkt) {
#pragma unroll
                for (int ks = 0; ks < 4; ++ks) bnx[ks] = *(const bf16x8*)(KI + (size_t)(key0 + 128 + c) * 64 + 16 * ks + 8 * h2); }
        } else {
#pragma unroll
            for (int ks = 0; ks < 4; ++ks) bfr[ks] = *(const bf16x8*)(KI + (size_t)(key0 + c) * 64 + 16 * ks + 8 * h2); }
        const unsigned voffb = (unsigned)(((2 * h2 + 4 * mt0) * 8192 + key0 + c) * 2);
        auto tile_body = [&](auto mc_) { constexpr bool MASKED = decltype(mc_)::v;
        f32x16 accl;
#pragma unroll
        for (int i = 0; i < 16; ++i) accl[i] = 0.f;
#pragma unroll
        for (int ks = 0; ks < 4; ++ks) accl = __builtin_amdgcn_mfma_f32_32x32x16_bf16(*(const LAS bf16x8*)(alin_p + 32 * ks), bfr[ks], accl, 0, 0, 0);
#pragma unroll
        for (int mt = 0; mt < 4; ++mt) {
            f32x16 acc;
#pragma unroll
            for (int i = 0; i < 16; ++i) acc[i] = 0.f;
#pragma unroll
            for (int ks = 0; ks < 4; ++ks) acc = __builtin_amdgcn_mfma_f32_32x32x16_bf16(afr[mt][ks], bfr[ks], acc, 0, 0, 0);
#pragma unroll
            for (int i = 0; i < 2; ++i) {
                const int q = 4 * (mt0 + mt) + 2 * h2 + i, qu = 4 * (mt0 + mt) + i;
                const f32x4 wa = (MODE != 1) ? wreg[mt][i][0] : *(const LAS f32x4*)(WQ + q * 8), wb = (MODE != 1) ? wreg[mt][i][1] : *(const LAS f32x4*)(WQ + q * 8 + 4);
                float s = wa[0] * __builtin_fabsf(acc[8 * i + 0]);
                s = __builtin_fmaf(wa[1], __builtin_fabsf(acc[8 * i + 1]), s); s = __builtin_fmaf(wa[2], __builtin_fabsf(acc[8 * i + 2]), s); s = __builtin_fmaf(wa[3], __builtin_fabsf(acc[8 * i + 3]), s);
                s = __builtin_fmaf(wb[0], __builtin_fabsf(acc[8 * i + 4]), s); s = __builtin_fmaf(wb[1], __builtin_fabsf(acc[8 * i + 5]), s); s = __builtin_fmaf(wb[2], __builtin_fabsf(acc[8 * i + 6]), s); s = __builtin_fmaf(wb[3], __builtin_fabsf(acc[8 * i + 7]), s);
                s = 0.5f * (s + accl[2 * mt + i]);
                const _Float16 hs = (_Float16)s; s = (float)hs;
                const unsigned lb = (unsigned)lin_bin(s);
                if (MODE == 0 && LVL0) *(unsigned short*)((unsigned char*)(scr + (4 * mt + i) * 8192) + voffb) = __builtin_bit_cast(unsigned short, hs);
                if (MODE == 0 && LVL0) {
                    unsigned inc = 1u << ((lb & 1u) << 4); if (MASKED) inc = (c2 <= qu) ? inc : 0u;
                    lds_add((LAS unsigned*)(hbase + (4 * mt + i) * 4096 + (lb >> 1) * 4), inc);
                } else if (MODE == 0) {
                    const unsigned key = f2key(s);
                    if (c2 <= qu && (int)(lb + 1u) == qa[mt][i] && (lvl == 1 || (key >> sh1) == ST[q * 8 + 0])) { const unsigned bin = (key >> sh2) & bmask; lds_add((LAS unsigned*)(hbase + (4 * mt + i) * 4096 + (bin >> 1) * 4), 1u << (16u * (bin & 1u))); }
                } else {
                    const unsigned st = (unsigned)qa[mt][i], thr1 = st & 0xffffu, lb1 = lb + 1u;
                    if (c2 <= qu && lb1 >= thr1) {
                        const unsigned key = f2key(s); bool sel = lb1 > thr1;
                        if (!sel) { const unsigned pfx = (unsigned)((unsigned long long)key >> (st >> 16)), px = ST[q * 8 + 0]; if (pfx < px) continue; sel = pfx > px; }
                        if (sel) { const unsigned slot = lds_add(&ST[q * 8 + 3], 1u); if (slot < 256u) OIDX[q * 256 + slot] = (unsigned short)(key0 + c); }
                        else { const unsigned slot = lds_add(&ST[q * 8 + 4], 1u); if (slot < DS_CAP) CAND[q * 512 + slot] = ((unsigned long long)key << 13) | (unsigned long long)(8191 - (key0 + c)); } }
                }
            }
        }
        };
        if (MODE == 0 && LVL0 && !lastt) tile_body(BoolC<false>{}); else tile_body(BoolC<true>{});
    }
}

__device__ __forceinline__ void dsa_resolve(LAS unsigned char* L, const LAS unsigned long long* CANDq, int q, int lane) {
    LAS unsigned* ST = (LAS unsigned*)(L + DS_ST); LAS unsigned short* OIDX = (LAS unsigned short*)(L + DS_OIDX);
    const unsigned plen = ST[q * 8 + 1];
    if (plen == DS_SELALL) return;
    const unsigned need = ST[q * 8 + 2], ncand = ST[q * 8 + 4], n = ncand < DS_CAP ? ncand : DS_CAP, prefix = ST[q * 8 + 0]; const int nj = (int)((n + 63u) >> 6);
    if (n <= 64u) {
        const unsigned long long v = (unsigned)lane < n ? CANDq[lane] : 0ull; const unsigned vlo = (unsigned)v, vhi = (unsigned)(v >> 32); unsigned rank = 0;
        for (unsigned j = 0; j < n; ++j) { const unsigned olo = __builtin_amdgcn_readlane(vlo, j), ohi = __builtin_amdgcn_readlane(vhi, j); const unsigned long long o = ((unsigned long long)ohi << 32) | olo; rank += (o > v) ? 1u : 0u; }
        if ((unsigned)lane < n && rank < need) { const unsigned slot = lds_add(&ST[q * 8 + 3], 1u); if (slot < 256u) OIDX[q * 256 + slot] = (unsigned short)(8191u - (unsigned)(v & 8191ull)); }
    } else {
        unsigned long long v[8];
#pragma unroll
        for (int j = 0; j < 8; ++j) { const unsigned idx = lane + 64 * j; v[j] = (j < nj && idx < n) ? CANDq[idx] : 0ull; }
        unsigned long long T = (plen >= 32u) ? ((unsigned long long)prefix << 13) : (plen == 0u ? 0ull : ((unsigned long long)prefix << (45u - plen)));
        for (int bit = 44 - (int)plen; bit >= 0; --bit) { const unsigned long long trial = T | (1ull << bit); unsigned cnt = 0;
#pragma unroll
            for (int j = 0; j < 8; ++j) if (j < nj) cnt += (unsigned)__popcll(__ballot(v[j] >= trial));
            if (cnt >= need) T = trial; }
#pragma unroll
        for (int j = 0; j < 8; ++j) if (j < nj && v[j] >= T && v[j] != 0ull) { const unsigned slot = lds_add(&ST[q * 8 + 3], 1u); if (slot < 256u) OIDX[q * 256 + slot] = (unsigned short)(8191u - (unsigned)(v[j] & 8191ull)); }
    }
}
__device__ __forceinline__ unsigned thresh_half(int T) { const _Float16 h = (_Float16)((float)(T - 1024) * (1.0f / 128.f)); const unsigned b = (unsigned)__builtin_bit_cast(unsigned short, h);
    return T <= 0 ? 0xFC00u : (T >= 2048 ? 0x7C00u : (T == 1024 ? 0x8004u : b)); }
typedef _Float16 half2_t __attribute__((ext_vector_type(2)));
template <int CTRL> __device__ __forceinline__ unsigned dppu(unsigned v) { return (unsigned)__builtin_amdgcn_update_dpp(0, (int)v, CTRL, 0xf, 0xf, true); }
__device__ __forceinline__ unsigned wave_incl_scan(unsigned v) {
    v += dppu<0x111>(v); v += dppu<0x112>(v); v += dppu<0x114>(v); v += dppu<0x118>(v);
    v += (unsigned)__builtin_amdgcn_update_dpp(0, (int)v, 0x142, 0xA, 0xF, false); v += (unsigned)__builtin_amdgcn_update_dpp(0, (int)v, 0x143, 0xC, 0xF, false); return v; }
__device__ __forceinline__ void dsa_emit_stored(const unsigned short* scr, int t0, LAS unsigned char* L, int w, int lane) {
    LAS unsigned* ST = (LAS unsigned*)(L + DS_ST); LAS unsigned short* OIDX = (LAS unsigned short*)(L + DS_OIDX);
    LAS unsigned* LIST = (LAS unsigned*)(L + DS_HIST + w * 16384); LAS unsigned long long* CANDW = (LAS unsigned long long*)(L + DS_HIST + w * 16384 + 4096);
    constexpr int RD = 4;
    u32x4 bufA[RD], bufB[RD];
    if (ST[(4 * w) * 8 + 1] != DS_SELALL) {
        const unsigned short* row0 = scr + (4 * w) * 8192 + lane * 16; const int nr0 = ((t0 + 4 * w) >> 10) + 1;
#pragma unroll
        for (int u = 0; u < RD; ++u) if (u < nr0) { bufA[u] = *(const u32x4*)(row0 + u * 1024); bufB[u] = *(const u32x4*)(row0 + u * 1024 + 8); } }
    for (int qi = 0; qi < 4; ++qi) { const int q = 4 * w + qi, t = t0 + q; const unsigned plen = ST[q * 8 + 1];
        if (plen == DS_SELALL) { for (int i = lane; i <= t; i += 64) OIDX[q * 256 + i] = (unsigned short)i; if (lane == 0) ST[q * 8 + 3] = (unsigned)(t + 1); continue; }
        const unsigned thr1 = ST[q * 8 + 6]; const unsigned h0 = thresh_half((int)thr1 - 1), h1 = thresh_half((int)thr1);
        const unsigned nh0 = (h0 ^ 0x8000u) * 0x10001u; const half2_t nh0v = __builtin_bit_cast(half2_t, nh0);
        const unsigned short* row = scr + q * 8192 + lane * 16; const int nr = (t >> 10) + 1;
        unsigned cnt = 0u;
        auto flags8 = [&](const u32x4& cur) -> unsigned { unsigned x[4];
#pragma unroll
            for (int k = 0; k < 4; ++k) { const unsigned ck = cur[k]; x[k] = __builtin_bit_cast(unsigned, __builtin_bit_cast(half2_t, ck) + nh0v); }
            const unsigned f01 = __builtin_amdgcn_perm(x[1], x[0], 0x07050301u) & 0x80808080u, f23 = __builtin_amdgcn_perm(x[3], x[2], 0x07050301u) & 0x80808080u;
            return (f01 | (f23 >> 1)) ^ 0xC0C0C0C0u; };
        auto vmask8 = [&](int nv) -> unsigned { const int na = nv < 0 ? 0 : (nv > 4 ? 4 : nv), nb = nv - 4 < 0 ? 0 : (nv - 4 > 4 ? 4 : nv - 4);
            return (0x80808080u & (unsigned)((1ull << (8 * na)) - 1ull)) | (0x40404040u & (unsigned)((1ull << (8 * nb)) - 1ull)); };
        auto drain8 = [&](unsigned pm, const u32x4& cur, unsigned idxb, unsigned& base) {
            while (pm) { const unsigned b = (unsigned)__builtin_ctz(pm); pm &= pm - 1u; const unsigned k = b >> 3, hq = (~b) & 1u;
                const unsigned long long pr = hq ? (((unsigned long long)cur[3] << 32) | cur[2]) : (((unsigned long long)cur[1] << 32) | cur[0]);
                const unsigned e = ((unsigned)(pr >> (16u * k)) << 16) | (idxb + k + 4u * hq);
                if (base < 1024u) LIST[base] = e; ++base; } };
        for (int r0 = 0; r0 < nr; r0 += RD) {
#pragma unroll
          for (int u = 0; u < RD; ++u) { const int r = r0 + u; if (r < nr) { const u32x4 curA = bufA[u], curB = bufB[u];
            if (r + RD < nr) { bufA[u] = *(const u32x4*)(row + (r + RD) * 1024); bufB[u] = *(const u32x4*)(row + (r + RD) * 1024 + 8); }
            const unsigned idx0 = (unsigned)(r * 1024 + lane * 16);
            unsigned pmA = flags8(curA), pmB = flags8(curB);
            if (r == nr - 1) { const int nv = t - (int)idx0 + 1; pmA &= vmask8(nv); pmB &= vmask8(nv - 8); }
            const unsigned c = (unsigned)__builtin_popcount(pmA) + (unsigned)__builtin_popcount(pmB); const unsigned inc = wave_incl_scan(c);
            unsigned base = cnt + inc - c; cnt += __builtin_amdgcn_readlane(inc, 63);
            drain8(pmA, curA, idx0, base); drain8(pmB, curB, idx0 + 8u, base);
          } } }
        if (qi < 3) { const unsigned short* rown = row + 8192; const int nrn = ((t + 1) >> 10) + 1;
#pragma unroll
            for (int u = 0; u < RD; ++u) if (u < nrn) { bufA[u] = *(const u32x4*)(rown + u * 1024); bufB[u] = *(const u32x4*)(rown + u * 1024 + 8); } }
        LDS_WAIT();
        const float h1f = (float)__builtin_bit_cast(_Float16, (unsigned short)h1); const unsigned n = cnt < 1024u ? cnt : 1024u; unsigned nsel = 0u, ncand = 0u;
        for (unsigned i0 = 0; i0 < n; i0 += 64u) { const unsigned i = i0 + (unsigned)lane; const bool in = i < n; const unsigned e = in ? LIST[i] : 0u;
            const float sr = (float)__builtin_bit_cast(_Float16, (unsigned short)(e >> 16)); const bool sel = in && sr >= h1f, cd = in && !(sr >= h1f);
            const unsigned long long m = __ballot((int)sel), mc = __ballot((int)cd);
            if (sel) { const unsigned slot = nsel + __builtin_amdgcn_mbcnt_hi((unsigned)(m >> 32), __builtin_amdgcn_mbcnt_lo((unsigned)m, 0u)); if (slot < 256u) OIDX[q * 256 + slot] = (unsigned short)(e & 8191u); }
            if (cd) { const unsigned slot = ncand + __builtin_amdgcn_mbcnt_hi((unsigned)(mc >> 32), __builtin_amdgcn_mbcnt_lo((unsigned)mc, 0u));
                if (slot < DS_CAP) CANDW[slot] = ((unsigned long long)f2key(sr) << 13) | (unsigned long long)(8191u - (e & 8191u)); }
            nsel += (unsigned)__popcll(m); ncand += (unsigned)__popcll(mc); }
        if (lane == 0) { ST[q * 8 + 3] = nsel; ST[q * 8 + 4] = ncand; }
        LDS_WAIT();
        dsa_resolve(L, CANDW, q, lane);
        LDS_WAIT();
    }
}

__device__ __forceinline__ void dsa_tile(const Frame& F, unsigned char* ws, int b, int tile) {
    LAS unsigned char* L = F.lds; const int tid = opq(F.tid), lane = tid & 63, w = F.wave;
    const int t0 = tile * 32; const size_t tokbase = (size_t)b * SEQ + t0;
    const bf16_t* QI = (const bf16_t*)(ws + WS_QI); const bf16_t* KI = (const bf16_t*)(ws + WS_KIDXN) + (size_t)b * SEQ * 64; const float* WIDX = (const float*)(ws + WS_WIDX);
    const bf16_t* QL = (const bf16_t*)(ws + WS_QL); const bf16_t* CKV = (const bf16_t*)(ws + WS_CKVN) + (size_t)b * SEQ * 128; bf16_t* A1 = (bf16_t*)(ws + WS_A1);
    LAS unsigned* HIST = (LAS unsigned*)(L + DS_HIST); LAS unsigned* ST = (LAS unsigned*)(L + DS_ST); LAS float* WQ = (LAS float*)(L + DS_WQ);
    LAS unsigned short* OIDX = (LAS unsigned short*)(L + DS_OIDX); LAS unsigned long long* CAND = (LAS unsigned long long*)(L + DS_HIST); LAS unsigned* PEND = (LAS unsigned*)(L + DS_PEND);
    unsigned short* scr = (unsigned short*)(ws + WS_SCR + (size_t)opq_s((int)blockIdx.x) * 524288);
    if (tid < 256) WQ[tid] = WIDX[tokbase * 8 + tid];
    if (tid < 8) PEND[tid] = 0u;
    LDS_BAR();
    if (tid < 32) { const bool selall = (t0 + tid + 1) <= 256; ST[tid * 8 + 0] = 0u; ST[tid * 8 + 1] = selall ? DS_SELALL : 0u; ST[tid * 8 + 2] = 256u; ST[tid * 8 + 3] = 0u; ST[tid * 8 + 4] = 0u; ST[tid * 8 + 5] = selall ? 1u : 0u; ST[tid * 8 + 6] = 0u;
        if (!selall) lds_or(&PEND[0], 1u); }
    {
      const int q = tid >> 4, d0 = (tid & 15) * 4; f32x4 acc4 = (f32x4){0.f, 0.f, 0.f, 0.f};
#pragma unroll
      for (int hh = 0; hh < 8; ++hh) { const u32x2 v = *(const u32x2*)(QI + (tokbase + q) * 512 + hh * 64 + d0); const float wv = WQ[q * 8 + hh];
          acc4[0] += wv * bflo(v.x); acc4[1] += wv * bfhi(v.x); acc4[2] += wv * bflo(v.y); acc4[3] += wv * bfhi(v.y); }
      *(LAS u32x2*)(L + DS_QBAR + q * 128 + d0 * 2) = pack4(acc4); }
#pragma unroll
    for (int j = 0; j < 16; ++j) *(LAS u32x4*)(L + DS_HIST + (size_t)(tid + 512 * j) * 16) = (u32x4){0u, 0u, 0u, 0u};
    bf16x8 afr[4][4];
    { const int h2 = lane >> 5, rho = lane & 31, ql = 2 * ((rho >> 2) & 1) + (rho >> 4), hd = 4 * ((rho >> 3) & 1) + (rho & 3);
#pragma unroll
      for (int mt = 0; mt < 4; ++mt)
#pragma unroll
          for (int ks = 0; ks < 4; ++ks) afr[mt][ks] = *(const bf16x8*)(QI + (tokbase + 4 * ((w >> 2) * 4 + mt) + ql) * 512 + hd * 64 + 16 * ks + 8 * h2); }
    LDS_BAR();
    const LAS unsigned char* alin;
    { const int h2 = lane >> 5, rho = lane & 15, hq = (rho >> 2) & 1, r = 4 * (rho >> 3) + (rho & 3), qq = 4 * ((w >> 2) * 4 + (r >> 1)) + 2 * hq + (r & 1); alin = L + DS_QBAR + qq * 128 + 16 * h2; }
    for (int lvl = 0; lvl < 4; ++lvl) {
        if (PEND[lvl] == 0u) break;
        if (lvl == 0) dsa_pass<0, true>(afr, alin, KI, t0, L, w, lane, 0, scr); else dsa_pass<0, false>(afr, alin, KI, t0, L, w, lane, lvl, scr);
#if DSA_DUP & 4
        if (lvl == 0) { LDS_BAR();
#pragma unroll
            for (int j = 0; j < 16; ++j) *(LAS u32x4*)(L + DS_HIST + (size_t)(tid + 512 * j) * 16) = (u32x4){0u, 0u, 0u, 0u};
            LDS_BAR(); dsa_pass<0, true>(afr, alin, KI, t0, L, w, lane, 0, scr); }
#endif
        WG_BAR();
        for (int qi = 0; qi < 4; ++qi) { const int q = 4 * w + qi;
            if (ST[q * 8 + 5] == 0u) { const unsigned plen = ST[q * 8 + 1], need = ST[q * 8 + 2], prefix = ST[q * 8 + 0];
                unsigned cnt = 0;
#pragma unroll
                for (int j = 0; j < 4; ++j) { const u32x4 v = *(const LAS u32x4*)(HIST + q * 1024 + lane * 16 + 4 * j);
                    cnt += (v.x & 0xffffu) + (v.x >> 16) + (v.y & 0xffffu) + (v.y >> 16) + (v.z & 0xffffu) + (v.z >> 16) + (v.w & 0xffffu) + (v.w >> 16); }
                const unsigned pre = wave_incl_scan(cnt), tot = (unsigned)__builtin_amdgcn_readlane((int)pre, 63);
                const unsigned s = tot - pre + cnt;
                const unsigned excl = s - cnt;
                if (excl < need && need <= s) { unsigned run = excl, thr = lane * 32, cin = 0;
                    for (int bin = lane * 32 + 31; bin >= lane * 32; --bin) { const unsigned cw = HIST[q * 1024 + (bin >> 1)], cb = (bin & 1) ? (cw >> 16) : (cw & 0xffffu);
                        if (run + cb >= need) { thr = bin; cin = cb; break; } run += cb; }
                    bool d;
                    if (lvl == 0) { ST[q * 8 + 6] = thr + 1u; d = cin <= DS_CAP; }
                    else { const unsigned nbits = lvl < 3 ? 11u : 10u, np = plen + nbits; d = (cin <= DS_CAP) || (np >= 32u); ST[q * 8 + 0] = (prefix << nbits) | thr; ST[q * 8 + 1] = np; }
                    ST[q * 8 + 2] = need - run; ST[q * 8 + 5] = d ? 1u : 0u;
                    if (!d) lds_or(&PEND[lvl + 1], 1u); }
            }
            LDS_WAIT();
#pragma unroll
            for (int j = 0; j < 4; ++j) *(LAS u32x4*)(HIST + q * 1024 + lane * 16 + 4 * j) = (u32x4){0u, 0u, 0u, 0u};
        }
        LDS_BAR();
    }
#if DSA_DUP & 2
    if (PEND[1] == 0u) dsa_emit_stored(scr, t0, L, w, opq(lane));
#endif
    if (PEND[1] == 0u) dsa_emit_stored(scr, t0, L, w, lane);
    else { dsa_pass<1, false>(afr, alin, KI, t0, L, w, lane, 0, scr); LDS_BAR();
        for (int qi = 0; qi < 4; ++qi) dsa_resolve(L, CAND + (4 * w + qi) * 512, 4 * w + qi, lane); }
    LDS_WAIT();
    LAS unsigned char* KVb = L + DS_HIST + w * 16384;
    const int lane0a = lane;
    {
        const int head = lane0a & 7;
        int gq = 0, gk = 0, cq = 0, ck = 0;
        unsigned nsq_[4];
#pragma unroll
        for (int qq = 0; qq < 4; ++qq) { unsigned n_ = ST[(4 * w + qq) * 8 + 3]; n_ = n_ < 256u ? n_ : 256u; nsq_[qq] = (unsigned)__builtin_amdgcn_readfirstlane((int)n_); }
#define DSA_NS(qi_) ((qi_) == 0 ? nsq_[0] : ((qi_) == 1 ? nsq_[1] : ((qi_) == 2 ? nsq_[2] : nsq_[3])))
#define DSA_ADV(q_, k_) do { const unsigned nn_ = DSA_NS(q_); if ((unsigned)(64 * ((k_) + 1)) < nn_) ++(k_); else { ++(q_); (k_) = 0; } } while (0)
#define DSA_GATHER(buf_) do { const int lg_ = opq(lane0a); const int q_ = 4 * w + gq; const unsigned ns_ = DSA_NS(gq); _Pragma("unroll") for (int jj = 0; jj < 16; ++jj) { const int pc = lg_ + 64 * jj, row = pc >> 4, ch = pc & 15; \
            const unsigned slot = 64 * gk + row; const unsigned kidx = slot < ns_ ? (unsigned)OIDX[q_ * 256 + slot] : 0u; buf_[jj] = *(const u32x4*)(CKV + (size_t)kidx * 128 + ch * 8); } DSA_ADV(gq, gk); } while (0)
        u32x4 tA[16], tB[16];
        bf16x8 bq[4]; float m_run = -1.0e30f, l_part = 0.f; f32x4 O[8];
        DSA_GATHER(tA);
        if (gq < 4) DSA_GATHER(tB);
        { const int g0 = lane0a >> 4;
#pragma unroll
          for (int ks = 0; ks < 4; ++ks) bq[ks] = *(const bf16x8*)(QL + (tokbase + 4 * w) * 1024 + head * 128 + 32 * ks + 8 * g0); }
        auto chunk = [&](const u32x4 (&buf)[16], bool more) {
            const int lane = opq(lane0a), g = lane >> 4, n16 = lane & 15;
            const int q = 4 * w + cq; const size_t tok = tokbase + q; const unsigned nsel = DSA_NS(cq); const int kc = ck;
            const bool lastc = (unsigned)(64 * (kc + 1)) >= nsel;
            (void)more;
            if (kc == 0) { m_run = -1.0e30f; l_part = 0.f;
#pragma unroll
                for (int mt = 0; mt < 8; ++mt) O[mt] = (f32x4){0.f, 0.f, 0.f, 0.f}; }
            f32x4 sc[4]; float cmax = -1.0e30f;
#pragma unroll
            for (int jt = 0; jt < 4; ++jt) { sc[jt] = (f32x4){0.f, 0.f, 0.f, 0.f};
#pragma unroll
                for (int ks = 0; ks < 4; ++ks) { const bf16x8 A = *(const LAS bf16x8*)(KVb + off_b(16 * jt + n16, 4 * ks + g)); sc[jt] = MFMA16(A, bq[ks], sc[jt]); }
#pragma unroll
                for (int i = 0; i < 4; ++i) { const unsigned slot = 64 * kc + 16 * jt + 4 * g + i; if (slot >= nsel) sc[jt][i] = -1.0e30f; cmax = fmaxf(cmax, sc[jt][i]); } }
            if (lastc && cq < 3) {
#pragma unroll
                for (int ks = 0; ks < 4; ++ks) bq[ks] = *(const bf16x8*)(QL + (tok + 1) * 1024 + (n16 & 7) * 128 + 32 * ks + 8 * g); }
            cmax = max_fq(cmax);
            const float m_new = fmaxf(m_run, cmax), alpha = fast_exp2((m_run - m_new) * 1.4426950408889634f); float ps = 0.f;
#pragma unroll
            for (int jt = 0; jt < 4; ++jt)
#pragma unroll
                for (int i = 0; i < 4; ++i) { const float p = fast_exp2((sc[jt][i] - m_new) * 1.4426950408889634f); sc[jt][i] = p; ps += p; }
            l_part = l_part * alpha + ps; m_run = m_new;
            bf16x8 Pf[2];
#pragma unroll
            for (int k2 = 0; k2 < 2; ++k2) Pf[k2] = __builtin_bit_cast(bf16x8, pack8(sc[2 * k2], sc[2 * k2 + 1]));
#pragma unroll
            for (int mt = 0; mt < 8; ++mt) { O[mt] = O[mt] * alpha;
#pragma unroll
                for (int k2 = 0; k2 < 2; ++k2) { const bf16x8 A = mk8(tr_blk(KVb, 32 * k2 + 4 * g, mt, lane), tr_blk(KVb, 32 * k2 + 16 + 4 * g, mt, lane)); O[mt] = MFMA16(A, Pf[k2], O[mt]); } }
            if (lastc) { const float inv = fast_rcp(red_fq(l_part));
                if (n16 < 8) {
#pragma unroll
                    for (int mt = 0; mt < 8; ++mt) *(u32x2*)(A1 + tok * 1536 + (n16 & 7) * 128 + 16 * mt + 4 * g) = pack4(O[mt] * inv); } }
            DSA_ADV(cq, ck);
        };
#define DSA_STAGE(buf_) do { const int ls_ = opq(lane0a); _Pragma("unroll") for (int jj = 0; jj < 16; ++jj) { const int pc = ls_ + 64 * jj, row = pc >> 4, ch = pc & 15; *(LAS u32x4*)(KVb + off_b(row, ch)) = buf_[jj]; } } while (0)
        for (;;) {
            DSA_STAGE(tA); if (gq < 4) DSA_GATHER(tA); chunk(tA, true); if (cq >= 4) break;
            DSA_STAGE(tB); if (gq < 4) DSA_GATHER(tB); chunk(tB, true); if (cq >= 4) break;
        }
#undef DSA_STAGE
#undef DSA_GATHER
#undef DSA_ADV
#undef DSA_NS
    }
    LDS_BAR();
}

#define NOINL __forceinline__
__device__ __forceinline__ Frame mk_frame(LAS unsigned char* lds) { Frame F; F.lds = lds; int t_ = threadIdx.x; asm volatile("" : "+v"(t_)); F.tid = t_; F.lane = F.tid & 63; F.wave = __builtin_amdgcn_readfirstlane(F.tid >> 6);
    F.G = gridDim.x; F.gw = blockIdx.x * NWAVES + F.wave; F.NGW = F.G * NWAVES; return F; }
__device__ NOINL void ph_prologue(LAS unsigned char* lds, unsigned char* ws) { const Frame F = mk_frame(lds); p0_prologue(F, ws); }
__device__ NOINL void ph_gemm_bf(LAS unsigned char* lds, unsigned char* ws, int which, int Gs, int cs_, int aux) {
    const int cs = opq_s(cs_);
    pg8::Gemm g; pg8::StaticOrder S; EpiBf E; E.split_pn = 99; E.O2 = nullptr; E.ldc2 = 0; E.rsv = nullptr; E.rs_mode = 0; E.pn_stride = 256;
    if (which == 0 || which == 7) { g = pg8::plain_gemm((const bf16_t*)(ws + WS_MEMB), (const bf16_t*)(ws + (which == 0 ? WS_W_XKT : WS_W_XVT)), 1024); S.init(8, 8, Gs, cs);
        E.O = (bf16_t*)(ws + (which == 0 ? WS_KM : WS_VT)); E.ldc = 2048; E.rsv = (const float*)(ws + WS_MEMRS); E.rs_mode = 2; }
    else if (which == 5) { g = pg8::plain_gemm((const bf16_t*)(ws + WS_CQN), (const bf16_t*)(ws + WS_W_Q1T), 256); if (Gs < 0) S.init_panel(6, cs); else S.init(256, 6, Gs, cs); E.O = (bf16_t*)(ws + WS_QL); E.ldc = 1024; E.split_pn = 4; E.O2 = (bf16_t*)(ws + WS_QI); E.ldc2 = 512; }
    else if (which == 6) { g = pg8::plain_gemm((const bf16_t*)(ws + WS_XB), (const bf16_t*)(ws + WS_W_IN1T), 1024); if (Gs < 0) S.init_panel(6, cs); else S.init(256, 6, Gs, cs); E.O = (bf16_t*)(ws + WS_P1RAW); E.ldc = 1536; E.rsv = (const float*)(ws + WS_RSP) + (size_t)3 * M * 4; E.rs_mode = 1; }
    else if (which == 8) { const int L = aux >> 2, h = aux & 3;
        g.A = (const bf16_t*)(ws + WS_KM) + (size_t)L * 1024 + h * 256; g.lda = 2048; g.a_pm = (size_t)256 * 2048 * 2; g.a_pn = 0;
        g.Bt = (const bf16_t*)(ws + WS_W_XQT) + (size_t)L * D * D + h * 256; g.ldb = 1024; g.b_pn = (size_t)256 * 1024 * 2; g.b_pm = 0; g.b_sh = 0; g.K = 256; S.init(8, 4, Gs, cs);
        E.O = (bf16_t*)(ws + WS_WQK) + (size_t)h * 2048 * 1024; E.ldc = 1024; }
    else { const int L = aux >> 2, h = aux & 3;
        g.A = (const bf16_t*)(ws + WS_W_XOT) + (size_t)L * D * D + h * 256; g.lda = 1024; g.a_pm = (size_t)256 * 1024 * 2; g.a_pn = 0;
        g.Bt = (const bf16_t*)(ws + WS_VT) + (size_t)L * 1024 + h * 256; g.ldb = 2048; g.b_pn = (size_t)256 * 2048 * 2; g.b_pm = 0; g.b_sh = 0; g.K = 256; S.init(4, 8, Gs, cs);
        E.O = (bf16_t*)(ws + WS_VWOT) + h * 256; E.ldc = 1024; E.pn_stride = 1024 * 1024; }
    pg8::gemm_phase(lds, g, S, E);
}
__device__ NOINL void ph_gemm_res(LAS unsigned char* lds, unsigned char* ws, float* out, const float* xin, int which) {
    pg8::Gemm g; pg8::StaticOrder S; if (which == 5 && gridDim.x == 256) S.init_panel(4, opq_s((int)blockIdx.x)); else S.init(256, 4, (int)gridDim.x, opq_s((int)blockIdx.x)); int slot;
    if (which == 0) { g = pg8::plain_gemm((const bf16_t*)(ws + (DBG_A0SRC == 1 ? WS_XB : WS_A0)), (const bf16_t*)(ws + WS_W_OUT0T), 1024); slot = 1;
        if (DBG_A0SRC == 2) { g.A += 512; g.K = 512; } if (DBG_A0SRC == 3) { g.K = 512; } }
    else if (which == 1) { g = pg8::plain_gemm((const bf16_t*)(ws + WS_A1), (const bf16_t*)(ws + WS_W_OUT1T), 1536); slot = 4; }
    else if (which <= 3) { const int L = which - 2; g = pg8::plain_gemm((const bf16_t*)(ws + WS_P), (const bf16_t*)(ws + WS_VWOT), 1024); g.b_pm = (size_t)1024 * 1024 * 2; g.b_sh = 5; slot = L ? 5 : 2; }
    else { const int L = which - 4; g = pg8::plain_gemm((const bf16_t*)(ws + WS_ACT), (const bf16_t*)(ws + WS_W_2T) + (size_t)L * D * FF, FF); slot = L ? 6 : 3; }
    (void)out; (void)xin; EpiRes E{(bf16_t*)(ws + WS_XB), (float*)(ws + WS_RSP) + (size_t)slot * M * 4}; pg8::gemm_phase(lds, g, S, E);
}
__device__ NOINL void ph_gemm_in0(LAS unsigned char* lds, unsigned char* ws) {
    pg8::Gemm g = pg8::plain_gemm((const bf16_t*)(ws + WS_XB), (const bf16_t*)(ws + WS_W_IN0T), 1024); pg8::StaticOrder S; S.init(256, 14, (int)gridDim.x, opq_s((int)blockIdx.x));
    EpiIn0 E{ws};
    pg8::gemm_phase(lds, g, S, E);
}
__device__ NOINL void ph_gemm_s(LAS unsigned char* lds, unsigned char* ws, int L) {
    pg8::Gemm g = pg8::plain_gemm((const bf16_t*)(ws + WS_XB), (const bf16_t*)(ws + WS_WQK), 1024); g.b_pn = (size_t)8 * 256 * 1024 * 2; g.b_pm = (size_t)256 * 1024 * 2; g.b_sh = 5;
    pg8::StaticOrder S; S.init(256, 4, (int)gridDim.x, opq_s((int)blockIdx.x));
    EpiS E{(bf16_t*)(ws + WS_P), (const float*)(ws + WS_RSP) + (size_t)(L ? 4 : 1) * M * 4}; pg8::gemm_phase(lds, g, S, E);
}
__device__ NOINL void ph_gemm_ffn1(LAS unsigned char* lds, unsigned char* ws, int L) {
    pg8::Gemm g = pg8::plain_gemm((const bf16_t*)(ws + WS_XB), (const bf16_t*)(ws + WS_W_13T) + (size_t)L * 5632 * D, 1024); pg8::StaticOrder S; S.init(256, 22, (int)gridDim.x, opq_s((int)blockIdx.x));
    EpiFfn1 E{(bf16_t*)(ws + WS_ACT), (const float*)(ws + WS_RSP) + (size_t)(L ? 5 : 2) * M * 4}; pg8::gemm_phase(lds, g, S, E);
}

__device__ NOINL void ph_post1(LAS unsigned char* lds, unsigned char* ws, int row0, int nrows) { const Frame F = mk_frame(lds);
    const bf16_t* P1 = (const bf16_t*)(ws + WS_P1RAW); bf16_t* CQN = (bf16_t*)(ws + WS_CQN); bf16_t* CKVN = (bf16_t*)(ws + WS_CKVN); bf16_t* KIDXN = (bf16_t*)(ws + WS_KIDXN); float* WIDX = (float*)(ws + WS_WIDX);
    bf16_t* U = (bf16_t*)(ws + WS_U); bf16_t* DVN = (bf16_t*)(ws + WS_DV);
    const int lane = F.lane; const bool is_cq = lane < 32, is_kv = lane >= 32 && lane < 48, is_ki = lane >= 48 && lane < 56, is_w = lane == 56;
    float g0[8], b0[8], vg[8], vb[8];
#pragma unroll
    for (int i = 0; i < 8; ++i) { g0[i] = is_kv ? INP(I_OCKVN)[(lane - 32) * 8 + i] : (is_ki ? INP(I_OIDXKG)[(lane - 48) * 8 + i] : 1.f); b0[i] = is_ki ? INP(I_OIDXKB)[(lane - 48) * 8 + i] : 0.f;
        vg[i] = INP(I_ODVG)[lane * 8 + i]; vb[i] = INP(I_ODVB)[lane * 8 + i]; }
    const int rstep = (nrows == M ? F.NGW : NWAVES), rfirst = row0 + (nrows == M ? F.gw : F.wave);
    u32x4 nx0, nx1, nx2;
    if (rfirst < row0 + nrows) { const bf16_t* pr = P1 + (size_t)rfirst * 1536; nx0 = *(const u32x4*)(pr + lane * 8); nx1 = *(const u32x4*)(pr + 512 + lane * 8); nx2 = *(const u32x4*)(pr + 1024 + lane * 8); }
    for (int row = rfirst; row < row0 + nrows; row += rstep) {
        const u32x4 c0 = nx0, c1 = nx1, c2 = nx2;
        if (row + rstep < row0 + nrows) { const bf16_t* pr = P1 + (size_t)(row + rstep) * 1536; nx0 = *(const u32x4*)(pr + lane * 8); nx1 = *(const u32x4*)(pr + 512 + lane * 8); nx2 = *(const u32x4*)(pr + 1024 + lane * 8); }
        float x0[8], x1[8], x2[8]; unpack8(c0, x0); unpack8(c1, x1); unpack8(c2, x2);
        float s0 = 0.f, q0 = 0.f, s2 = 0.f, q2 = 0.f;
#pragma unroll
        for (int i = 0; i < 8; ++i) { s0 += x0[i]; q0 += x0[i] * x0[i]; x1[i] = gelu_f(x1[i]); x2[i] = gelu_f(x2[i]); s2 += x2[i]; q2 += x2[i] * x2[i]; }
        const float ss_cq = wave_sum(is_cq ? q0 : 0.f), ss_kv = wave_sum(is_kv ? q0 : 0.f), s_ki = wave_sum(is_ki ? s0 : 0.f), q_ki = wave_sum(is_ki ? q0 : 0.f);
        s2 = wave_sum(s2); q2 = wave_sum(q2);
        const float mean_ki = s_ki * (1.0f / 64.f), var_ki = q_ki * (1.0f / 64.f) - mean_ki * mean_ki;
        const float sc0 = is_cq ? fast_rsq(ss_cq * (1.0f / 256.f) + 1e-6f) : (is_kv ? fast_rsq(ss_kv * (1.0f / 128.f) + 1e-6f) : (is_ki ? fast_rsq(fmaxf(var_ki, 0.f) + 1e-5f) : 0.35355339059327373f));
        const float sub0 = is_ki ? mean_ki : 0.f;
#pragma unroll
        for (int i = 0; i < 8; ++i) x0[i] = (x0[i] - sub0) * sc0 * g0[i] + b0[i];
        if (is_cq) *(u32x4*)(CQN + (size_t)row * 256 + lane * 8) = pack8f(x0);
        else if (is_kv) *(u32x4*)(CKVN + (size_t)row * 128 + (lane - 32) * 8) = pack8f(x0);
        else if (is_ki) *(u32x4*)(KIDXN + (size_t)row * 64 + (lane - 48) * 8) = pack8f(x0);
        else if (is_w) { *(f32x4*)(WIDX + (size_t)row * 8) = (f32x4){x0[0], x0[1], x0[2], x0[3]}; *(f32x4*)(WIDX + (size_t)row * 8 + 4) = (f32x4){x0[4], x0[5], x0[6], x0[7]}; }
        *(u32x4*)(U + (size_t)row * 512 + lane * 8) = pack8f(x1);
        const float mean2 = s2 * (1.0f / 512.f), var2 = q2 * (1.0f / 512.f) - mean2 * mean2, rstd2 = fast_rsq(fmaxf(var2, 0.f) + 1e-5f);
#pragma unroll
        for (int i = 0; i < 8; ++i) x2[i] = (x2[i] - mean2) * rstd2 * vg[i] + vb[i];
        *(u32x4*)(DVN + (size_t)row * 512 + lane * 8) = pack8f(x2);
    }
}
__device__ NOINL void ph_hgrn(LAS unsigned char* lds, unsigned char* ws, int unit) { const Frame F = mk_frame(lds); hgrn_unit(F, ws, unit); }
__device__ NOINL void ph_hgrnA(LAS unsigned char* lds, unsigned char* ws, int unit) { const Frame F = mk_frame(lds); hgrn_passA(F, ws, unit); }
__device__ NOINL void ph_conv(LAS unsigned char* lds, unsigned char* ws, int wg, int nwg) { const Frame F = mk_frame(lds); conv_part(F, ws, wg, nwg); }
__device__ NOINL void ph_fin(LAS unsigned char* lds, unsigned char* ws) { const Frame F = mk_frame(lds); hgrn_finalize(F, ws); }
__device__ NOINL void ph_gmlp(LAS unsigned char* lds, unsigned char* ws, int panel) { const Frame F = mk_frame(lds);
    u32x4 da[4], db[4];
    if (panel >= 0) { gmlp_load(F, ws, 8 * panel, da);
        for (int k = 0; k < 8; k += 2) { gmlp_unit(F, ws, 8 * panel + k, da, db, 8 * panel + k + 1); gmlp_unit(F, ws, 8 * panel + k + 1, db, da, k + 2 < 8 ? 8 * panel + k + 2 : -1); } }
    else for (int u = blockIdx.x; u < 2048; u += F.G) { gmlp_load(F, ws, u, da); gmlp_unit(F, ws, u, da, db, -1); } }
__device__ NOINL void ph_dsa(LAS unsigned char* lds, unsigned char* ws) { const Frame F = mk_frame(lds);
    for (int tl = blockIdx.x; tl < 2048; tl += F.G) { const int b = tl & 7, idx = tl >> 3, i = idx >> 5, j = idx & 31; dsa_tile(F, ws, b, (i & 1) ? 32 * i + 31 - j : 32 * i + j); } }
__device__ NOINL void ph_final(LAS unsigned char* lds, unsigned char* ws, float* out, int slot, int row0, int nrows) { const Frame F = mk_frame(lds);
    const float* rsp = (const float*)(ws + WS_RSP) + (size_t)slot * M * 4; const float* fg = INP(I_FINAL);
    f32x4 gv[4];
#pragma unroll
    for (int j = 0; j < 4; ++j) gv[j] = *((const f32x4*)fg + F.lane + 64 * j);
    const int rstep = (nrows == M ? F.NGW : NWAVES), rfirst = row0 + (nrows == M ? F.gw : F.wave);
    f32x4 np; u32x2 nx[4];
    if (rfirst < row0 + nrows) { np = *(const f32x4*)(rsp + (size_t)rfirst * 4); const u32x2* xs = (const u32x2*)((const bf16_t*)(ws + WS_XB) + (size_t)rfirst * D) + F.lane;
#pragma unroll
        for (int j = 0; j < 4; ++j) nx[j] = xs[64 * j]; }
    for (int row = rfirst; row < row0 + nrows; row += rstep) { const f32x4 p = np; u32x2 cx4[4];
#pragma unroll
        for (int j = 0; j < 4; ++j) cx4[j] = nx[j];
        if (row + rstep < row0 + nrows) { np = *(const f32x4*)(rsp + (size_t)(row + rstep) * 4); const u32x2* xs = (const u32x2*)((const bf16_t*)(ws + WS_XB) + (size_t)(row + rstep) * D) + F.lane;
#pragma unroll
            for (int j = 0; j < 4; ++j) nx[j] = xs[64 * j]; }
        const float rs = fast_rsq(((p[0] + p[1]) + (p[2] + p[3])) * (1.0f / 1024.f) + 1e-6f);
        f32x4* xr = (f32x4*)(out + (size_t)row * D) + F.lane;
#pragma unroll
        for (int j = 0; j < 4; ++j) { const u32x2 xo = cx4[j]; xr[64 * j] = (f32x4){bflo(xo.x), bfhi(xo.x), bflo(xo.y), bfhi(xo.y)} * rs * gv[j]; } }
}

constexpr int N_PHASES = 23;

#ifndef PH_MASK
#define PH_MASK 0xffffffffu
#endif
#define EN(k) (((PH_MASK) >> (k)) & 1u)
#ifndef DUP_MASK
#define DUP_MASK 0x0u
#endif
#define DUP(k) (((DUP_MASK) >> (k)) & 1u)
__global__ void __launch_bounds__(NTHR, 2) mk_fwd(Args args) {
    extern __shared__ __attribute__((aligned(16))) unsigned char lds_raw[];
    LAS unsigned char* lds = (LAS unsigned char*)lds_raw;
#define KARG ((const volatile __attribute__((address_space(4))) Args*)__builtin_amdgcn_kernarg_segment_ptr())
#define ws ((unsigned char*)KARG->ws)
#define out ((float*)KARG->out)
    const int G = gridDim.x, bx = blockIdx.x, tid = threadIdx.x;
    volatile LAS unsigned* MISC = (volatile LAS unsigned*)(lds + MISC_OFF);
    if (tid < 64) MISC[tid] = 0u;
    if (tid < 32) *(const float* LAS*)(lds + PTAB_OFF + 8 * tid) = args.in[tid];
    __syncthreads();
#if MK_N_LAUNCHES == 1
    (void)xcd_barrier_post((unsigned*)(ws + WS_CTL) + CW_BAR, MISC + 8);
#define GRID_BAR() do { XcdBarrier b_; unsigned char* wso_ = ws; b_.bar = (unsigned*)(wso_ + WS_CTL) + CW_BAR; b_.x = xb_xcc_id(); b_.st = (volatile LAS unsigned*)(lds + MISC_OFF) + 8; xcd_barrier(b_); } while (0)
#else
#define GRID_BAR() do { } while (0)
#endif
    const int lo = (MK_N_LAUNCHES == 1) ? 0 : args.ph_lo, hi = (MK_N_LAUNCHES == 1) ? N_PHASES : args.ph_hi;
#define IN(k) (lo <= (k) && (k) < hi)
#define SEAM(k) do { if (IN(k) && IN((k) + 1)) GRID_BAR(); } while (0)
    if (EN(0) && IN(0)) { ph_prologue(lds, ws); if (DUP(0)) { GRID_BAR(); ph_prologue(lds, ws); } }
    SEAM(0);
#pragma unroll
    for (int L = 0; L < 2; ++L) {
        if (L == 0) {
            if (EN(1) && IN(1)) { const int half = G / 2; if (EN(23)) { if (bx < half) ph_gemm_bf(lds, ws, 0, half, bx, 0); else ph_gemm_bf(lds, ws, 7, G - half, bx - half, 0); } if (EN(24)) ph_gemm_in0(lds, ws); if (DUP(1)) { GRID_BAR(); ph_gemm_in0(lds, ws); } }
            SEAM(1);
            if (EN(2) && IN(2)) { for (int u = bx; u < 256; u += G) ph_hgrnA(lds, ws, u); ph_conv(lds, ws, bx, G); GRID_BAR(); for (int u = bx; u < 256; u += G) ph_hgrn(lds, ws, u); }
            SEAM(3);
            if (EN(4) && IN(4)) { { const int q4 = G / 4, hh = bx / q4, cc = bx % q4; if (hh < 4) { ph_gemm_bf(lds, ws, 8, q4, cc, hh); ph_gemm_bf(lds, ws, 9, q4, cc, hh); } }
                ph_gemm_res(lds, ws, out, (const float*)KARG->in[I_X], 0); }
            SEAM(4);
        } else {
            if (G == 256) {
                if (IN(11)) { ph_gemm_bf(lds, ws, 6, -1, bx, 0); ph_post1(lds, ws, 256 * bx, 256); WG_BAR(); ph_gemm_bf(lds, ws, 5, -1, bx, 0); ph_gmlp(lds, ws, bx); }
            } else {
            if (EN(11) && IN(11)) ph_gemm_bf(lds, ws, 6, G, bx, 0);
            SEAM(11);
            if (EN(15) && IN(12)) { ph_post1(lds, ws, 0, M); }
            SEAM(12);
            if (EN(12) && IN(13)) { if (EN(25)) ph_gemm_bf(lds, ws, 5, G, bx, 0); if (EN(22)) ph_gmlp(lds, ws, -1); }
            }
            SEAM(13);
            if (EN(13) && IN(14)) { ph_dsa(lds, ws); if (DUP(13)) { GRID_BAR(); ph_dsa(lds, ws); } }
            SEAM(14);
            if (EN(14) && IN(15)) { { const int q4 = G / 4, hh = bx / q4, cc = bx % q4; if (hh < 4) { ph_gemm_bf(lds, ws, 8, q4, cc, 4 + hh); ph_gemm_bf(lds, ws, 9, q4, cc, 4 + hh); } }
                ph_gemm_res(lds, ws, out, out, 1); }
            SEAM(15);
        }
        const int pb = L ? 16 : 5;
        if (EN(6) && IN(pb + 1)) { ph_gemm_s(lds, ws, L); if (DUP(6)) { GRID_BAR(); ph_gemm_s(lds, ws, L); } }
        SEAM(pb + 1);
        if (EN(8) && IN(pb + 3)) ph_gemm_res(lds, ws, out, out, 2 + L);
        SEAM(pb + 3);
        if (EN(9) && IN(pb + 4)) { ph_gemm_ffn1(lds, ws, L); if (DUP(9)) { GRID_BAR(); ph_gemm_ffn1(lds, ws, L); } }
        SEAM(pb + 4);
        if (EN(10) && IN(pb + 5)) ph_gemm_res(lds, ws, out, out, 4 + L);
        if (!(L == 1 && G == 256)) SEAM(pb + 5);
    }
    if (EN(21) && IN(22)) { if (G == 256) ph_final(lds, ws, out, 6, 256 * bx, 256); else ph_final(lds, ws, out, 6, 0, M); }
#undef ws
#undef out
#undef KARG
#undef IN
#undef SEAM
}

extern "C" void kernel_launch(void* const* d_in, const int* in_sizes, int n_in, void* d_out, int out_size, void* d_ws, size_t ws_size, hipStream_t stream) {
    static int grid = 0;
    if (grid == 0) {
        if (n_in != N_IN || in_sizes[0] != M * D || out_size != M * D || ws_size < WS_END) { fprintf(stderr, "kernel_launch: unexpected shapes (n_in %d, in0 %d, out %d, ws %zu)\n", n_in, n_in > 0 ? in_sizes[0] : -1, out_size, ws_size); grid = -1; return; }
        int dev = 0, cus = 0, per_cu = 0;
        if (hipGetDevice(&dev) != hipSuccess || hipDeviceGetAttribute(&cus, hipDeviceAttributeMultiprocessorCount, dev) != hipSuccess) { grid = -1; return; }
        if (hipFuncSetAttribute((const void*)mk_fwd, hipFuncAttributeMaxDynamicSharedMemorySize, LDS_BYTES) != hipSuccess) { fprintf(stderr, "kernel_launch: hipFuncSetAttribute failed\n"); grid = -1; return; }
        if (hipOccupancyMaxActiveBlocksPerMultiprocessor(&per_cu, (const void*)mk_fwd, NTHR, LDS_BYTES) != hipSuccess || per_cu < 1) fprintf(stderr, "kernel_launch: occupancy query reports %d\n", per_cu);
        (void)hipGetLastError();
        grid = cus;
        if (grid != 256) fprintf(stderr, "kernel_launch: %d CUs (built for 256)\n", grid);
    }
    if (grid < 0) return;
    if (hipMemsetAsync((char*)d_ws + WS_CTL, 0, CTL_ZERO_BYTES, stream) != hipSuccess) return;
    Args a{};
    for (int i = 0; i < N_IN; ++i) a.in[i] = (const float*)d_in[i];
    a.out = (float*)d_out; a.ws = (unsigned char*)d_ws; a.fin_slot = TRUNC_SLOT;
#if MK_N_LAUNCHES == 1
    a.ph_lo = 0; a.ph_hi = N_PHASES;
    hipLaunchKernelGGL(mk_fwd, dim3(grid), dim3(NTHR), LDS_BYTES, stream, a);
#else
    for (int p = 0; p < N_PHASES; ++p) { if (!((LAUNCH_MASK >> p) & 1u)) continue; a.ph_lo = p; a.ph_hi = p + 1; hipLaunchKernelGGL(mk_fwd, dim3(grid), dim3(NTHR), LDS_BYTES, stream, a); }
#endif
}
```
